# Optimizing an MI355X kernel written in HIP

```python
import jax, jax.numpy as jnp
from jax import lax
import numpy as np

D_MODEL = 1024
BATCH = 8
SEQ = 4096
DEPTH = 2
DEC_BATCH = 16
DEC_SEQ = 2048
PAST_LEN = 128

D_FF = 2816
BLOCK = 128
SGU_WIDTH = 512
SGU_GROUPS = 4
SGU_GROUP_DIM = SGU_WIDTH // SGU_GROUPS
HEAD_DIM = 64
ATT_HEADS = 8
ATT_KV_HEADS = 2
ATT_REP = ATT_HEADS // ATT_KV_HEADS
WINDOW = 128
ROPE_THETA = 500000.0
ROPE_DIM = HEAD_DIM // 4
AB_IN = 2 * SGU_WIDTH + (ATT_HEADS + 2 * ATT_KV_HEADS) * HEAD_DIM
AB_OUT = SGU_WIDTH + ATT_HEADS * HEAD_DIM
NA_HEADS = 16
NA_WIDTH = NA_HEADS * HEAD_DIM
NA_KH = 8
NA_KW = 16
GRID_W = 64
EPS = 1e-6
NEG_INF = -1e30

kernel_name = "hybrid_bidir_encoder_gmlp_swa_natten_macaron"


def rmsnorm(x, g):
    x32 = x.astype(jnp.float32)
    y = x32 * lax.rsqrt(jnp.mean(x32 * x32, axis=-1, keepdims=True) + EPS)
    return y.astype(x.dtype) * g


def layer_norm(x, g, b):
    x32 = x.astype(jnp.float32)
    mu = jnp.mean(x32, axis=-1, keepdims=True)
    var = jnp.mean(jnp.square(x32 - mu), axis=-1, keepdims=True)
    y = (x32 - mu) * lax.rsqrt(var + EPS)
    return y.astype(x.dtype) * g + b


def swiglu(h, wg, wu, wd):
    return (jax.nn.silu(h @ wg) * (h @ wu)) @ wd


def rope_partial(x):
    L = x.shape[1]
    inv = jnp.power(ROPE_THETA, -jnp.arange(0, ROPE_DIM, 2, dtype=jnp.float32) / ROPE_DIM)
    ang = jnp.arange(L, dtype=jnp.float32)[:, None] * inv[None, :]
    cos = jnp.cos(ang)[None, :, None, :]
    sin = jnp.sin(ang)[None, :, None, :]
    xr = x[..., :ROPE_DIM].astype(jnp.float32)
    x1, x2 = xr[..., :ROPE_DIM // 2], xr[..., ROPE_DIM // 2:]
    rot = jnp.concatenate([x1 * cos - x2 * sin, x2 * cos + x1 * sin], axis=-1).astype(x.dtype)
    return jnp.concatenate([rot, x[..., ROPE_DIM:]], axis=-1)


def window_gqa(q, k, v, sink):
    B, L = q.shape[0], q.shape[1]
    nb = L // BLOCK
    qb = q.reshape(B, nb, BLOCK, ATT_KV_HEADS, ATT_REP, HEAD_DIM)
    pad = ((0, 0), (BLOCK, BLOCK), (0, 0), (0, 0))
    kp = jnp.pad(k, pad).reshape(B, nb + 2, BLOCK, ATT_KV_HEADS, HEAD_DIM)
    vp = jnp.pad(v, pad).reshape(B, nb + 2, BLOCK, ATT_KV_HEADS, HEAD_DIM)
    kw = jnp.concatenate([kp[:, :-2], kp[:, 1:-1], kp[:, 2:]], axis=2)
    vw = jnp.concatenate([vp[:, :-2], vp[:, 1:-1], vp[:, 2:]], axis=2)
    s = jnp.einsum('bnqgrd,bnkgd->bngrqk', qb, kw).astype(jnp.float32) * (HEAD_DIM ** -0.5)
    qpos = jnp.arange(nb)[:, None] * BLOCK + jnp.arange(BLOCK)[None, :]
    kpos = (jnp.arange(nb)[:, None] - 1) * BLOCK + jnp.arange(3 * BLOCK)[None, :]
    rel = kpos[:, None, :] - qpos[:, :, None]
    valid = (jnp.abs(rel) <= WINDOW) & (kpos[:, None, :] >= 0) & (kpos[:, None, :] < L)
    s = jnp.where(valid[None, :, None, None], s, NEG_INF)
    sink_b = sink.astype(jnp.float32).reshape(ATT_KV_HEADS, ATT_REP)[None, None, :, :, None, None]
    sink_b = jnp.broadcast_to(sink_b, s.shape[:-1] + (1,))
    p = jax.nn.softmax(jnp.concatenate([s, sink_b], axis=-1), axis=-1)[..., :-1]
    o = jnp.einsum('bngrqk,bnkgd->bnqgrd', p.astype(v.dtype), vw)
    return o.reshape(B, L, ATT_HEADS * HEAD_DIM)


def neighbourhood_attn(q, k, v, rpb):
    B, L = q.shape[0], q.shape[1]
    rows = L // GRID_W
    kh = min(NA_KH, rows)
    qg = q.reshape(B, rows, GRID_W, NA_HEADS, HEAD_DIM)
    kg = k.reshape(B, rows, GRID_W, NA_HEADS, HEAD_DIM)
    vg = v.reshape(B, rows, GRID_W, NA_HEADS, HEAD_DIM)
    col_start = jnp.clip(jnp.arange(GRID_W) - NA_KW // 2, 0, GRID_W - NA_KW)
    col_idx = col_start[:, None] + jnp.arange(NA_KW)[None, :]
    dc = col_idx - jnp.arange(GRID_W)[:, None] + (NA_KW - 1)
    row_start = jnp.clip(jnp.arange(rows) - kh // 2, 0, rows - kh)

    def one_row(args):
        r, rs, q_row = args
        k_band = lax.dynamic_slice_in_dim(kg, rs, kh, axis=1)
        v_band = lax.dynamic_slice_in_dim(vg, rs, kh, axis=1)
        k_win = k_band[:, :, col_idx]
        v_win = v_band[:, :, col_idx]
        dr = rs + jnp.arange(kh) - r + (NA_KH - 1)
        bias = rpb[:, dr][:, :, dc]
        s = jnp.einsum('bchd,bacjhd->bhcaj', q_row, k_win).astype(jnp.float32) * (HEAD_DIM ** -0.5)
        s = s + jnp.transpose(bias, (0, 2, 1, 3)).astype(jnp.float32)[None]
        p = jax.nn.softmax(s.reshape(B, NA_HEADS, GRID_W, kh * NA_KW), axis=-1)
        p = p.reshape(B, NA_HEADS, GRID_W, kh, NA_KW).astype(v.dtype)
        return jnp.einsum('bhcaj,bacjhd->bchd', p, v_win)

    out = lax.map(one_row, (jnp.arange(rows), row_start, jnp.transpose(qg, (1, 0, 2, 3, 4))))
    return jnp.transpose(out, (1, 0, 2, 3, 4)).reshape(B, L, NA_WIDTH)


def mixer_ab(h, w_in, sgu_ln_g, sgu_ln_b, sgu_w, sgu_b, sink, w_out):
    B, L, _ = h.shape
    z = h @ w_in
    zs = jax.nn.gelu(z[..., :2 * SGU_WIDTH], approximate=False)
    u, vh = zs[..., :SGU_WIDTH], zs[..., SGU_WIDTH:]
    vh = layer_norm(vh, sgu_ln_g, sgu_ln_b)
    nc = L // BLOCK
    vh = vh.reshape(B, nc, BLOCK, SGU_GROUPS, SGU_GROUP_DIM)
    vmix = jnp.einsum('gij,bnjgc->bnigc', sgu_w, vh) + jnp.transpose(sgu_b)[None, None, :, :, None]
    a_out = u * vmix.reshape(B, L, SGU_WIDTH)
    o = 2 * SGU_WIDTH
    q = z[..., o:o + ATT_HEADS * HEAD_DIM].reshape(B, L, ATT_HEADS, HEAD_DIM)
    o = o + ATT_HEADS * HEAD_DIM
    k = z[..., o:o + ATT_KV_HEADS * HEAD_DIM].reshape(B, L, ATT_KV_HEADS, HEAD_DIM)
    o = o + ATT_KV_HEADS * HEAD_DIM
    v = z[..., o:o + ATT_KV_HEADS * HEAD_DIM].reshape(B, L, ATT_KV_HEADS, HEAD_DIM)
    b_out = window_gqa(rope_partial(q), rope_partial(k), v, sink)
    return jnp.concatenate([a_out, b_out], axis=-1) @ w_out


def mixer_c(h, w_qkv, rpb, w_out):
    B, L, _ = h.shape
    qkv = (h @ w_qkv).reshape(B, L, 3, NA_HEADS, HEAD_DIM)
    o = neighbourhood_attn(qkv[:, :, 0], qkv[:, :, 1], qkv[:, :, 2], rpb)
    return o @ w_out


def even_layer(x, f1_n, f1_g, f1_u, f1_d, mix_n, w_in, sgu_ln_g, sgu_ln_b, sgu_w, sgu_b, sink, w_out,
               f2_n, f2_g, f2_u, f2_d):
    x = x + 0.5 * swiglu(rmsnorm(x, f1_n), f1_g, f1_u, f1_d)
    x = x + mixer_ab(rmsnorm(x, mix_n), w_in, sgu_ln_g, sgu_ln_b, sgu_w, sgu_b, sink, w_out)
    x = x + 0.5 * swiglu(rmsnorm(x, f2_n), f2_g, f2_u, f2_d)
    return x


def odd_layer(x, f1_n, f1_g, f1_u, f1_d, mix_n, w_qkv, rpb, w_out, f2_n, f2_g, f2_u, f2_d):
    x = x + 0.5 * swiglu(rmsnorm(x, f1_n), f1_g, f1_u, f1_d)
    x = x + mixer_c(rmsnorm(x, mix_n), w_qkv, rpb, w_out)
    x = x + 0.5 * swiglu(rmsnorm(x, f2_n), f2_g, f2_u, f2_d)
    return x


def trunk(x, layer_params, final_norm):
    for layer in range(DEPTH):
        if layer % 2 == 0:
            x = even_layer(x, *layer_params[layer])
        else:
            x = odd_layer(x, *layer_params[layer])
    return rmsnorm(x, final_norm)


def _w(key, shape, fan_in):
    return jax.random.normal(key, shape, jnp.float32) * (fan_in ** -0.5)


def _gain(key, shape):
    return 1.0 + 0.02 * jax.random.normal(key, shape, jnp.float32)


def setup_inputs(seed: int = 0) -> dict:
    key = jax.random.key(seed)
    ks = jax.random.split(key, 40)
    d = {}
    d['x_prompt'] = jax.random.normal(ks[0], (BATCH, SEQ, D_MODEL), jnp.float32)
    d['x_sample'] = jax.random.normal(ks[1], (DEC_BATCH, DEC_SEQ, D_MODEL), jnp.float32)
    d['l0_ffn1_norm'] = _gain(ks[2], (D_MODEL,))
    d['l0_ffn1_w_gate'] = _w(ks[3], (D_MODEL, D_FF), D_MODEL)
    d['l0_ffn1_w_up'] = _w(ks[4], (D_MODEL, D_FF), D_MODEL)
    d['l0_ffn1_w_down'] = _w(ks[5], (D_FF, D_MODEL), D_FF)
    d['l0_mix_norm'] = _gain(ks[6], (D_MODEL,))
    d['l0_w_in'] = _w(ks[7], (D_MODEL, AB_IN), D_MODEL)
    d['l0_sgu_ln_g'] = _gain(ks[8], (SGU_WIDTH,))
    d['l0_sgu_ln_b'] = 0.02 * jax.random.normal(ks[9], (SGU_WIDTH,), jnp.float32)
    d['l0_sgu_w'] = _w(ks[10], (SGU_GROUPS, BLOCK, BLOCK), BLOCK)
    d['l0_sgu_b'] = _gain(ks[11], (SGU_GROUPS, BLOCK))
    d['l0_sink'] = 0.5 * jax.random.normal(ks[12], (ATT_HEADS,), jnp.float32)
    d['l0_w_out'] = _w(ks[13], (AB_OUT, D_MODEL), AB_OUT)
    d['l0_ffn2_norm'] = _gain(ks[14], (D_MODEL,))
    d['l0_ffn2_w_gate'] = _w(ks[15], (D_MODEL, D_FF), D_MODEL)
    d['l0_ffn2_w_up'] = _w(ks[16], (D_MODEL, D_FF), D_MODEL)
    d['l0_ffn2_w_down'] = _w(ks[17], (D_FF, D_MODEL), D_FF)
    d['l1_ffn1_norm'] = _gain(ks[18], (D_MODEL,))
    d['l1_ffn1_w_gate'] = _w(ks[19], (D_MODEL, D_FF), D_MODEL)
    d['l1_ffn1_w_up'] = _w(ks[20], (D_MODEL, D_FF), D_MODEL)
    d['l1_ffn1_w_down'] = _w(ks[21], (D_FF, D_MODEL), D_FF)
    d['l1_mix_norm'] = _gain(ks[22], (D_MODEL,))
    d['l1_w_qkv'] = _w(ks[23], (D_MODEL, 3 * NA_WIDTH), D_MODEL)
    d['l1_rpb'] = 0.5 * jax.random.normal(ks[24], (NA_HEADS, 2 * NA_KH - 1, 2 * NA_KW - 1), jnp.float32)
    d['l1_w_out'] = _w(ks[25], (NA_WIDTH, D_MODEL), NA_WIDTH)
    d['l1_ffn2_norm'] = _gain(ks[26], (D_MODEL,))
    d['l1_ffn2_w_gate'] = _w(ks[27], (D_MODEL, D_FF), D_MODEL)
    d['l1_ffn2_w_up'] = _w(ks[28], (D_MODEL, D_FF), D_MODEL)
    d['l1_ffn2_w_down'] = _w(ks[29], (D_FF, D_MODEL), D_FF)
    d['final_norm'] = _gain(ks[30], (D_MODEL,))
    return d


def reference(x_prompt, x_sample,
              l0_ffn1_norm, l0_ffn1_w_gate, l0_ffn1_w_up, l0_ffn1_w_down,
              l0_mix_norm, l0_w_in, l0_sgu_ln_g, l0_sgu_ln_b, l0_sgu_w, l0_sgu_b, l0_sink, l0_w_out,
              l0_ffn2_norm, l0_ffn2_w_gate, l0_ffn2_w_up, l0_ffn2_w_down,
              l1_ffn1_norm, l1_ffn1_w_gate, l1_ffn1_w_up, l1_ffn1_w_down,
              l1_mix_norm, l1_w_qkv, l1_rpb, l1_w_out,
              l1_ffn2_norm, l1_ffn2_w_gate, l1_ffn2_w_up, l1_ffn2_w_down,
              final_norm):
    p0 = (l0_ffn1_norm, l0_ffn1_w_gate, l0_ffn1_w_up, l0_ffn1_w_down,
          l0_mix_norm, l0_w_in, l0_sgu_ln_g, l0_sgu_ln_b, l0_sgu_w, l0_sgu_b, l0_sink, l0_w_out,
          l0_ffn2_norm, l0_ffn2_w_gate, l0_ffn2_w_up, l0_ffn2_w_down)
    p1 = (l1_ffn1_norm, l1_ffn1_w_gate, l1_ffn1_w_up, l1_ffn1_w_down,
          l1_mix_norm, l1_w_qkv, l1_rpb, l1_w_out,
          l1_ffn2_norm, l1_ffn2_w_gate, l1_ffn2_w_up, l1_ffn2_w_down)
    layer_params = [p0, p1]
    y_prompt = trunk(x_prompt, layer_params, final_norm)
    y_sample = trunk(x_sample, layer_params, final_norm)
    return (y_prompt, y_sample)
```

```cpp
#include <hip/hip_runtime.h>
#include <hip/hip_cooperative_groups.h>
#include <cstdio>
#include <cstdint>
namespace cg = cooperative_groups;

#ifndef MK_SINGLE
#define MK_SINGLE 1
#endif

#define GAS __attribute__((address_space(1)))
namespace pg8 {
#define PG8_LAS __attribute__((address_space(3)))
typedef unsigned short bf16_t;
typedef short bf16x8 __attribute__((ext_vector_type(8)));
typedef float f32x4 __attribute__((ext_vector_type(4)));
typedef unsigned u32x4 __attribute__((ext_vector_type(4)));
constexpr int BM = 256, BK = 64, HALF = 128, HTB = HALF * BK * 2  , STAGE_BYTES = 8 * HTB, NXCD = 8, WGM = 8;

__host__ __device__ __forceinline__ int lds_byte(int r, int c) { const int st = (r >> 4) * 2 + (c >> 5), rr = r & 15, cc = c & 31, ob = rr * 64 + cc * 2; return st * 1024 + (ob ^ (((ob >> 9) & 1) << 5)); }
__host__ __device__ __forceinline__ void stage_rc(int b, int& R, int& C) { const int st = b / 1024, sb = b % 1024, swz = sb ^ (((sb >> 9) & 1) << 5); R = (st >> 1) * 16 + swz / 64; C = (st & 1) * 32 + (swz % 64) / 2; }
__host__ __device__ __forceinline__ int perm32(int rho) { const int n = rho >> 4, i = rho & 15; return 8 * (i >> 2) + 4 * n + (i & 3); }

struct Unit { int pm, pn; };
struct Gemm { const bf16_t* A; const bf16_t* Bt; int M, N, K; int tiledA; };

struct StaticOrder {
    int nM, nN, nwg, G, c;
    __host__ __device__ void init(int M, int N, int G_, int c_) { nM = M / BM; nN = N / BM; nwg = nM * nN; G = G_; c = c_; }
    __host__ __device__ bool next(int i, Unit& u) const {
        const long L = (long)i * G + c; if (L >= nwg) return false;
        int wgid = (int)L; { const int q = nwg / NXCD, r = nwg % NXCD, xcd = wgid % NXCD, off = wgid / NXCD; wgid = (xcd < r ? xcd * (q + 1) : r * (q + 1) + (xcd - r) * q) + off; }
        const int nig = WGM * nN, gid = wgid / nig, fm = gid * WGM, gsz = (nM - fm) < WGM ? (nM - fm) : WGM;
        u.pm = fm + ((wgid % nig) % gsz); u.pn = (wgid % nig) / gsz; return true;
    }
    __device__ __forceinline__ void a_ready(const Unit&) const {}
    __device__ __forceinline__ void done(const Unit&) const {}
};
__device__ __forceinline__ unsigned cvt_pk_bf16(float lo, float hi) { unsigned r; asm volatile("v_cvt_pk_bf16_f32 %0, %1, %2" : "=v"(r) : "v"(lo), "v"(hi)); return r; }
typedef float f32x2 __attribute__((ext_vector_type(2)));
__device__ __forceinline__ f32x2 gelu_pk(f32x2 v) {
    const f32x2 av = __builtin_elementwise_abs(v), d = av * 0.2316418882f + 1.0f;
    f32x2 t; t.x = __builtin_amdgcn_rcpf(d.x); t.y = __builtin_amdgcn_rcpf(d.y);
    f32x2 q = t * 0.5307027145f + (-0.7265760135f); q = q * t + 0.7107068705f; q = q * t + (-0.142248368f); q = q * t + 0.127414796f; q = q * t;
    const f32x2 s = (v * v) * (-0.72134752044f);
    f32x2 e; e.x = __builtin_amdgcn_exp2f(s.x); e.y = __builtin_amdgcn_exp2f(s.y);
    const f32x2 m = v * (q * e), r = v - m;
    f32x2 o; o.x = v.x < 0.f ? m.x : r.x; o.y = v.y < 0.f ? m.y : r.y; return o;
}

__device__ __forceinline__ unsigned pk_bf16(float lo, float hi) { typedef __bf16 bf2 __attribute__((ext_vector_type(2))); f32x2 v = {lo, hi}; bf2 b = __builtin_convertvector(v, bf2); return __builtin_bit_cast(unsigned, b); }
__device__ __forceinline__ float silu_mul(float g, float u) { return g * __builtin_amdgcn_rcpf(1.0f + __builtin_amdgcn_exp2f(-1.4426950408889634f * g)) * u; }

struct EpiSwiGLU {
    static constexpr bool PERM = true, AFTER_DRAIN = false;
    bf16_t* H; int ldh; const PG8_LAS float* rl;
    __device__ __forceinline__ void operator()(const f32x4 (&acc)[2][2][4][2], const Unit& u, int wr, int wc, int fr, int fq, int ui) const {
        const int row0 = u.pm * BM + wr * 64 + fr, col0 = u.pn * HALF + wc * 32 + 8 * fq;
        const PG8_LAS float* rp = rl + ui * 256 + wr * 64 + fr;
#pragma unroll
        for (int ai = 0; ai < 2; ++ai)
#pragma unroll
            for (int m = 0; m < 4; ++m) {
                bf16_t* p = H + ((size_t)(2 * u.pm + ai) * (ldh >> 5) + 4 * u.pn + wc) * 4096 + (wr * 64 + m * 16 + fr) * 32 + 8 * fq;
                const float rr = rp[ai * HALF + m * 16], c1 = -1.4426950408889634f * rr, ic2 = __builtin_amdgcn_rcpf(rr * rr);
                f32x4 hv[2];
#pragma unroll
                for (int n = 0; n < 2; ++n) {
                    const f32x4 g = acc[ai][0][m][n], uu = acc[ai][1][m][n];
                    f32x4 e = g * c1;
                    e = (f32x4){__builtin_amdgcn_exp2f(e[0]), __builtin_amdgcn_exp2f(e[1]), __builtin_amdgcn_exp2f(e[2]), __builtin_amdgcn_exp2f(e[3])};
                    const f32x4 d = e * ic2 + ic2;
                    const f32x4 r = {__builtin_amdgcn_rcpf(d[0]), __builtin_amdgcn_rcpf(d[1]), __builtin_amdgcn_rcpf(d[2]), __builtin_amdgcn_rcpf(d[3])};
                    hv[n] = (g * uu) * r;
                }
                u32x4 w;
                w.x = pk_bf16(hv[0][0], hv[0][1]); w.y = pk_bf16(hv[0][2], hv[0][3]); w.z = pk_bf16(hv[1][0], hv[1][1]); w.w = pk_bf16(hv[1][2], hv[1][3]);
                __builtin_nontemporal_store(w, (GAS u32x4*)p);
            }
    }
};
struct EpiResidual {
    static constexpr bool PERM = true, AFTER_DRAIN = false;
    float scale; bf16_t* XB; float* SSP; bf16_t* XBo;
    __device__ __forceinline__ void operator()(const f32x4 (&acc)[2][2][4][2], const Unit& u, int wr, int wc, int fr, int fq, int ui) const {
        const int row0 = u.pm * BM + wr * 64 + fr;
#pragma unroll
        for (int ai = 0; ai < 2; ++ai) {
            u32x4 xb[4][2];
#pragma unroll
            for (int m = 0; m < 4; ++m)
#pragma unroll
                for (int bj = 0; bj < 2; ++bj) xb[m][bj] = *(const GAS u32x4*)(XB + ((size_t)(2 * u.pm + ai) * 32 + 8 * u.pn + 4 * bj + wc) * 4096 + (wr * 64 + m * 16 + fr) * 32 + 8 * fq);
#pragma unroll
            for (int m = 0; m < 4; ++m) {
                const int row = row0 + ai * HALF + m * 16;
                float ss = 0.f;
#pragma unroll
                for (int bj = 0; bj < 2; ++bj) {
                    const u32x4 b = xb[m][bj];
                    const f32x4 a0 = {__builtin_bit_cast(float, b.x << 16), __builtin_bit_cast(float, b.x & 0xffff0000u), __builtin_bit_cast(float, b.y << 16), __builtin_bit_cast(float, b.y & 0xffff0000u)};
                    const f32x4 a1 = {__builtin_bit_cast(float, b.z << 16), __builtin_bit_cast(float, b.z & 0xffff0000u), __builtin_bit_cast(float, b.w << 16), __builtin_bit_cast(float, b.w & 0xffff0000u)};
                    const f32x4 o0 = a0 + acc[ai][bj][m][0] * scale, o1 = a1 + acc[ai][bj][m][1] * scale;
                    ss += (o0[0] * o0[0] + o0[1] * o0[1]) + (o0[2] * o0[2] + o0[3] * o0[3]) + (o1[0] * o1[0] + o1[1] * o1[1]) + (o1[2] * o1[2] + o1[3] * o1[3]);
                    u32x4 w; w.x = pk_bf16(o0[0], o0[1]); w.y = pk_bf16(o0[2], o0[3]); w.z = pk_bf16(o1[0], o1[1]); w.w = pk_bf16(o1[2], o1[3]);
                    *(GAS u32x4*)(XBo + ((size_t)(2 * u.pm + ai) * 32 + 8 * u.pn + 4 * bj + wc) * 4096 + (wr * 64 + m * 16 + fr) * 32 + 8 * fq) = w;
                }
                { const unsigned sb = __builtin_bit_cast(unsigned, ss); auto r16 = __builtin_amdgcn_permlane16_swap(sb, sb, false, false);
                  ss = __builtin_bit_cast(float, (unsigned)r16[0]) + __builtin_bit_cast(float, (unsigned)r16[1]);
                  const unsigned sc = __builtin_bit_cast(unsigned, ss); auto r32 = __builtin_amdgcn_permlane32_swap(sc, sc, false, false);
                  ss = __builtin_bit_cast(float, (unsigned)r32[0]) + __builtin_bit_cast(float, (unsigned)r32[1]); }
                if (fq == 0) ((GAS float*)SSP)[(size_t)row * 16 + u.pn * 4 + wc] = ss;
            }
        }
    }
};
struct EpiBf16G {
    static constexpr bool PERM = true, AFTER_DRAIN = false;
    bf16_t* O; int ldc; int gelu_tiles; const PG8_LAS float* rl; int split_tiles; bf16_t* O2; int ldc2;
    __device__ __forceinline__ void operator()(const f32x4 (&acc)[2][2][4][2], const Unit& u, int wr, int wc, int fr, int fq, int ui) const {
        const bool second = u.pn >= split_tiles;
        bf16_t* const Ob = second ? O2 : O; const int ld = second ? ldc2 : ldc;
        const int pnl = second ? u.pn - split_tiles : u.pn, nslab = ld >> 5;
        const PG8_LAS float* rp = rl + ui * 256 + wr * 64 + fr;
        const bool act = u.pn < gelu_tiles;
#pragma unroll
        for (int ai = 0; ai < 2; ++ai)
#pragma unroll
            for (int m = 0; m < 4; ++m) {
                bf16_t* rowp = Ob + ((size_t)(2 * u.pm + ai) * nslab + 8 * pnl + wc) * 4096 + (wr * 64 + m * 16 + fr) * 32 + 8 * fq;
                const float rr = rp[ai * HALF + m * 16];
#pragma unroll
                for (int bj = 0; bj < 2; ++bj) {
                    f32x4 v0 = acc[ai][bj][m][0] * rr, v1 = acc[ai][bj][m][1] * rr;
                    if (act) { f32x2 a = gelu_pk((f32x2){v0[0], v0[1]}), b = gelu_pk((f32x2){v0[2], v0[3]}), c = gelu_pk((f32x2){v1[0], v1[1]}), d = gelu_pk((f32x2){v1[2], v1[3]});
                        v0 = (f32x4){a.x, a.y, b.x, b.y}; v1 = (f32x4){c.x, c.y, d.x, d.y}; }
                    u32x4 w; w.x = pk_bf16(v0[0], v0[1]); w.y = pk_bf16(v0[2], v0[3]); w.z = pk_bf16(v1[0], v1[1]); w.w = pk_bf16(v1[2], v1[3]);
                    __builtin_nontemporal_store(w, (GAS u32x4*)(rowp + bj * 4 * 4096));
                }
            }
    }
};

template <class Epi, class Sched, bool ALIGN_EPI = false, bool SP2 = false>
__device__ __forceinline__ void gemm_phase(PG8_LAS unsigned char* lds, const Gemm g, const Sched& S, const Epi& E) {
    int tid = threadIdx.x; asm volatile("" : "+v"(tid));
    const int wid = __builtin_amdgcn_readfirstlane(tid >> 6), lane = tid & 63, wr = wid >> 2, wc = wid & 3, fr = lane & 15, fq = lane >> 4;
    const int K = g.K, nt = K / BK;
    unsigned voffA[2], voffB[2];
#pragma unroll
    for (int i = 0; i < 2; ++i) { int R, C; stage_rc(tid * 16 + i * 8192, R, C); const int Rb = Epi::PERM ? ((R & ~31) + perm32(R & 31)) : R;
        voffA[i] = g.tiledA ? (unsigned)((C >> 5) * 8192 + R * 64 + (C & 31) * 2) : (unsigned)(R * K + C) * 2u; voffB[i] = (unsigned)(Rb * K + C) * 2u; }
    const size_t kstep = (size_t)(BK * 2);
    const size_t kstepA = g.tiledA ? (size_t)16384 : kstep;
    const size_t hstep = (size_t)HALF * K * 2;
    const size_t tstep = 2 * hstep;
    const unsigned ldsw = (unsigned)wid * 1024u;
    const int aoff = lds_byte(wr * 64 + fr, fq * 8), boff = lds_byte(wc * 32 + fr, fq * 8);
#define PG8_SA(b, h) (((b) * 2 + (h)) * HTB)
#define PG8_SB(b, h) ((4 + (b) * 2 + (h)) * HTB)
#define PG8_STAGE(bufoff, gbase, voff) do { _Pragma("unroll") for (int _i = 0; _i < 2; ++_i) \
        __builtin_amdgcn_global_load_lds((const unsigned*)((const char*)(gbase) + (voff)[_i]), (PG8_LAS unsigned*)(lds + (bufoff) + ldsw + _i * 8192), 16, 0, 0); } while (0)
#define PG8_LDA(dst, b, h) do { _Pragma("unroll") for (int m = 0; m < 4; ++m) _Pragma("unroll") for (int k = 0; k < 2; ++k) dst[m][k] = *(const PG8_LAS bf16x8*)(lds + PG8_SA(b, h) + aoff + m * 2048 + k * 1024); } while (0)
#define PG8_LDB(dst, b, h) do { _Pragma("unroll") for (int n = 0; n < 2; ++n) _Pragma("unroll") for (int k = 0; k < 2; ++k) dst[n][k] = *(const PG8_LAS bf16x8*)(lds + PG8_SB(b, h) + boff + n * 2048 + k * 1024); } while (0)
#define PG8_MMA(ai, bj, At, Bt) do { __builtin_amdgcn_s_setprio(1); _Pragma("unroll") for (int m = 0; m < 4; ++m) _Pragma("unroll") for (int n = 0; n < 2; ++n) _Pragma("unroll") for (int k = 0; k < 2; ++k) \
        acc[ai][bj][m][n] = __builtin_amdgcn_mfma_f32_16x16x32_bf16(Bt[n][k], At[m][k], acc[ai][bj][m][n], 0, 0, 0); __builtin_amdgcn_s_setprio(0); } while (0)
#define PG8_WAIT_V(n) asm volatile("s_waitcnt vmcnt(" #n ")" ::: "memory")
#define PG8_WAIT_L(n) asm volatile("s_waitcnt lgkmcnt(" #n ")" ::: "memory")
#define PG8_BAR __builtin_amdgcn_s_barrier()
#define PG8_SCHED __builtin_amdgcn_sched_barrier(0)
    Unit cur, nxt; int ui = 0;
    if (!S.next(0, cur)) return;
    f32x4 acc[2][2][4][2];
#pragma unroll
    for (int a = 0; a < 2; ++a)
#pragma unroll
        for (int b = 0; b < 2; ++b)
#pragma unroll
            for (int m = 0; m < 4; ++m)
#pragma unroll
                for (int n = 0; n < 2; ++n) acc[a][b][m][n] = (f32x4){0.f, 0.f, 0.f, 0.f};
    bf16x8 At[4][2], B0[2][2], B1[2][2];
    const char* cA = (const char*)g.A + (size_t)cur.pm * tstep; const char* cB = (const char*)g.Bt + (size_t)cur.pn * tstep;
    S.a_ready(cur);
    if constexpr (SP2) {
        PG8_STAGE(PG8_SB(0, 0), cB, voffB); PG8_STAGE(PG8_SB(0, 1), cB + hstep, voffB); PG8_STAGE(PG8_SA(0, 0), cA, voffA); PG8_STAGE(PG8_SA(0, 1), cA + hstep, voffA);
        if (wr == 1) PG8_BAR;
        PG8_WAIT_V(2); PG8_BAR;
        PG8_STAGE(PG8_SB(1, 0), cB + kstep, voffB); PG8_STAGE(PG8_SA(1, 0), cA + kstepA, voffA); PG8_STAGE(PG8_SB(1, 1), cB + hstep + kstep, voffB);
        PG8_WAIT_V(6); PG8_BAR;
    } else {
        PG8_STAGE(PG8_SB(0, 0), cB, voffB); PG8_STAGE(PG8_SA(0, 0), cA, voffA); PG8_STAGE(PG8_SB(0, 1), cB + hstep, voffB); PG8_STAGE(PG8_SA(0, 1), cA + hstep, voffA);
        if (wr == 1) PG8_BAR;
        PG8_WAIT_V(4); PG8_BAR;
        PG8_STAGE(PG8_SB(1, 0), cB + kstep, voffB); PG8_STAGE(PG8_SA(1, 0), cA + kstepA, voffA); PG8_STAGE(PG8_SB(1, 1), cB + hstep + kstep, voffB);
        PG8_WAIT_V(6); PG8_BAR;
    }
    for (;;) {
        const bool has_next = S.next(ui + 1, nxt);
        const char* nA = has_next ? (const char*)g.A + (size_t)nxt.pm * tstep : cA; const char* nB = has_next ? (const char*)g.Bt + (size_t)nxt.pn * tstep : cB;
        for (int t = 0; t < nt; t += 2) {
            const bool last = (t == nt - 2);
            const char* a1 = cA + (size_t)(t + 1) * kstepA;
            const char* a2 = last ? nA : cA + (size_t)(t + 2) * kstepA; const char* b2 = last ? nB : cB + (size_t)(t + 2) * kstep;
            const char* a3 = a2 + kstepA; const char* b3 = b2 + kstep;
            if (last && has_next) S.a_ready(nxt);
            if constexpr (SP2) {
            PG8_LDB(B0, 0, 0); PG8_LDB(B1, 0, 1); PG8_SCHED; PG8_LDA(At, 0, 0); PG8_STAGE(PG8_SA(1, 1), a1 + hstep, voffA);
            PG8_WAIT_V(8); PG8_WAIT_L(0); PG8_BAR; PG8_MMA(0, 0, At, B0); PG8_MMA(0, 1, At, B1); PG8_BAR; PG8_SCHED;
            PG8_LDA(At, 0, 1); PG8_STAGE(PG8_SB(0, 0), b2, voffB); PG8_STAGE(PG8_SB(0, 1), b2 + hstep, voffB); PG8_STAGE(PG8_SA(0, 0), a2, voffA);
            PG8_WAIT_V(8); PG8_WAIT_L(0); PG8_BAR; PG8_MMA(1, 0, At, B0); PG8_MMA(1, 1, At, B1); PG8_BAR; PG8_SCHED;
            PG8_LDB(B0, 1, 0); PG8_LDB(B1, 1, 1); PG8_SCHED; PG8_LDA(At, 1, 0); PG8_STAGE(PG8_SA(0, 1), a2 + hstep, voffA);
            PG8_WAIT_V(8); PG8_WAIT_L(0); PG8_BAR; PG8_MMA(0, 0, At, B0); PG8_MMA(0, 1, At, B1); PG8_BAR; PG8_SCHED;
            PG8_LDA(At, 1, 1); PG8_STAGE(PG8_SB(1, 0), b3, voffB); PG8_STAGE(PG8_SB(1, 1), b3 + hstep, voffB); PG8_STAGE(PG8_SA(1, 0), a3, voffA);
            PG8_WAIT_V(8); PG8_WAIT_L(0); PG8_BAR; PG8_MMA(1, 0, At, B0); PG8_MMA(1, 1, At, B1); PG8_BAR; PG8_SCHED;
            } else {
            PG8_LDB(B0, 0, 0); PG8_SCHED; PG8_LDA(At, 0, 0); PG8_STAGE(PG8_SA(1, 1), a1 + hstep, voffA);
            PG8_WAIT_L(8); PG8_BAR; PG8_WAIT_L(0); PG8_MMA(0, 0, At, B0); PG8_BAR; PG8_SCHED;
            PG8_LDB(B1, 0, 1); PG8_STAGE(PG8_SB(0, 0), b2, voffB);
            PG8_BAR; PG8_WAIT_L(0); PG8_MMA(0, 1, At, B1); PG8_BAR;
            PG8_LDA(At, 0, 1); PG8_STAGE(PG8_SA(0, 0), a2, voffA);
            PG8_BAR; PG8_WAIT_L(0); PG8_MMA(1, 0, At, B0); PG8_BAR; PG8_SCHED;
            PG8_STAGE(PG8_SB(0, 1), b2 + hstep, voffB);
            PG8_WAIT_V(6); PG8_BAR; PG8_MMA(1, 1, At, B1); PG8_BAR;
            PG8_LDB(B0, 1, 0); PG8_SCHED; PG8_LDA(At, 1, 0); PG8_STAGE(PG8_SA(0, 1), a2 + hstep, voffA);
            PG8_WAIT_L(8); PG8_BAR; PG8_WAIT_L(0); PG8_MMA(0, 0, At, B0); PG8_BAR; PG8_SCHED;
            PG8_LDB(B1, 1, 1); PG8_STAGE(PG8_SB(1, 0), b3, voffB);
            PG8_BAR; PG8_WAIT_L(0); PG8_MMA(0, 1, At, B1); PG8_BAR;
            PG8_LDA(At, 1, 1); PG8_STAGE(PG8_SA(1, 0), a3, voffA);
            PG8_BAR; PG8_WAIT_L(0); PG8_MMA(1, 0, At, B0); PG8_BAR; PG8_SCHED;
            PG8_STAGE(PG8_SB(1, 1), b3 + hstep, voffB);
            PG8_WAIT_V(6); PG8_BAR; PG8_MMA(1, 1, At, B1); PG8_BAR;
            }
        }
        if constexpr (ALIGN_EPI) { if (wr == 0) PG8_BAR; }
        if constexpr (!Epi::AFTER_DRAIN) { E(acc, cur, wr, wc, fr, fq, ui); S.done(cur); }
        if (!has_next) break;
#pragma unroll
        for (int a = 0; a < 2; ++a)
#pragma unroll
            for (int b = 0; b < 2; ++b)
#pragma unroll
                for (int m = 0; m < 4; ++m)
#pragma unroll
                    for (int n = 0; n < 2; ++n) acc[a][b][m][n] = (f32x4){0.f, 0.f, 0.f, 0.f};
        cur = nxt; cA = nA; cB = nB; ++ui;
        if constexpr (ALIGN_EPI) { if (wr == 1) PG8_BAR; }
    }
    PG8_WAIT_V(0);
    if constexpr (!ALIGN_EPI) { if (wr == 0) PG8_BAR; }
    PG8_BAR;
    if constexpr (Epi::AFTER_DRAIN) { E.fused(acc, cur, wr, wc, fr, fq, lds, wid, lane); S.done(cur); }
#undef PG8_SA
#undef PG8_SB
#undef PG8_STAGE
#undef PG8_LDA
#undef PG8_LDB
#undef PG8_MMA
#undef PG8_WAIT_V
#undef PG8_WAIT_L
#undef PG8_BAR
#undef PG8_SCHED
}
}

#define DI __device__ __forceinline__
#define LAS __attribute__((address_space(3)))
typedef unsigned short bf16_t;
typedef short bf16x8 __attribute__((ext_vector_type(8)));
typedef short s16x4 __attribute__((ext_vector_type(4)));
typedef float f32x4 __attribute__((ext_vector_type(4)));
typedef float f32x2 __attribute__((ext_vector_type(2)));
typedef float f32x16 __attribute__((ext_vector_type(16)));
typedef unsigned u32x4 __attribute__((ext_vector_type(4)));
typedef unsigned u32x2 __attribute__((ext_vector_type(2)));
using pg8::pk_bf16;

constexpr int NWAVES = 8, NTHREADS = 512;
constexpr int DM = 1024, DFF = 2816, MH = 32768;
constexpr int ZW = 1792, QKVW = 3072;
constexpr float EPS = 1e-6f, LOG2E = 1.4426950408889634f, C2 = 0.125f * 1.4426950408889634f;
constexpr size_t MiB = 1u << 20;
constexpr int MT = 2 * MH;
constexpr size_t WS_ROPE_C = 1 * MiB, WS_ROPE_S = 1 * MiB + 131072, WS_SGUW = 1 * MiB + 524288;
constexpr size_t WS_WGU = 2 * MiB, WGU_STRIDE = 11 * MiB;
constexpr size_t WS_WD = 46 * MiB, WD_STRIDE = 5 * MiB + 524288;
constexpr size_t WS_WIN = 68 * MiB, WS_WOUT0 = 72 * MiB, WS_WQKV = 74 * MiB, WS_WOUT1 = 80 * MiB;
constexpr size_t WS_XN = 0;
constexpr size_t WS_BIG = 128 * MiB;
constexpr size_t WS_AB = WS_BIG + 224 * MiB;
constexpr size_t WS_KV = WS_BIG + 64 * MiB;
constexpr size_t WS_CTL = 480 * MiB;
constexpr size_t WS_SSP = 481 * MiB;
constexpr size_t WS_END = 485 * MiB;
constexpr int RL_OFF = 131072, RL_UNITS = 24;
constexpr int MISC_OFF = RL_OFF + RL_UNITS * 1024;
constexpr int LDS_BYTES = MISC_OFF + 64;
constexpr int NPHASES = 19;

DI float bf2f(unsigned short v) { return __builtin_bit_cast(float, (unsigned)v << 16); }
DI float bflo(unsigned v) { return __builtin_bit_cast(float, v << 16); }
DI float bfhi(unsigned v) { return __builtin_bit_cast(float, v & 0xffff0000u); }
DI float wave_sum(float v) {
#pragma unroll
    for (int o = 1; o < 64; o <<= 1) v += __shfl_xor(v, o);
    return v;
}
DI int clampi(int v, int lo, int hi) { return v < lo ? lo : (v > hi ? hi : v); }
DI int crow(int reg, int h) { return (reg & 3) + 8 * (reg >> 2) + 4 * h; }
DI size_t toff(size_t row, int col, int nslab) { return ((row >> 7) * nslab + (col >> 5)) * 4096 + (row & 127) * 32 + (col & 31); }
#define LDS_BARRIER() do { asm volatile("s_waitcnt lgkmcnt(0)" ::: "memory"); __builtin_amdgcn_s_barrier(); asm volatile("" ::: "memory"); } while (0)
#define MFMA32(a, b, c) __builtin_amdgcn_mfma_f32_32x32x16_bf16((a), (b), (c), 0, 0, 0)
DI s16x4 tr_read(LAS const char* p) { return __builtin_bit_cast(s16x4, __builtin_amdgcn_ds_read_tr16_b64_v4i16((LAS s16x4*)p)); }
typedef float f32x8 __attribute__((ext_vector_type(8)));
DI float hsum16(const f32x16& t) {
    const f32x8 a = __builtin_shufflevector(t, t, 0, 1, 2, 3, 4, 5, 6, 7) + __builtin_shufflevector(t, t, 8, 9, 10, 11, 12, 13, 14, 15);
    const f32x4 b = __builtin_shufflevector(a, a, 0, 1, 2, 3) + __builtin_shufflevector(a, a, 4, 5, 6, 7);
    const f32x2 c = __builtin_shufflevector(b, b, 0, 1) + __builtin_shufflevector(b, b, 2, 3);
    return c.x + c.y;
}
DI bf16x8 pack8(const f32x16& x, int s) {
    u32x4 p; p.x = pk_bf16(x[8 * s], x[8 * s + 1]); p.y = pk_bf16(x[8 * s + 2], x[8 * s + 3]); p.z = pk_bf16(x[8 * s + 4], x[8 * s + 5]); p.w = pk_bf16(x[8 * s + 6], x[8 * s + 7]);
    return __builtin_bit_cast(bf16x8, p);
}

DI void p0_transpose_item(const float* W, int K, int N, bf16_t* WT, int mode, LAS float* scr, int item, int lane, const float* gain = nullptr) {
    const int nblk = N / 32, kb = item / nblk, nb = item % nblk, k0 = 64 * kb, n0 = 32 * nb;
    const int drow0 = mode == 0 ? n0 : (256 * (n0 >> 7) + (n0 & 127) + (mode == 2 ? 128 : 0));
#pragma unroll 8
    for (int i = 0; i < 32; ++i) { const int kk = 2 * i + (lane >> 5); scr[kk * 33 + (lane & 31)] = ((const GAS float*)W)[(size_t)(k0 + kk) * N + n0 + (lane & 31)] * (gain ? ((const GAS float*)gain)[k0 + kk] : 1.0f); }
    asm volatile("s_waitcnt lgkmcnt(0)" ::: "memory");
    const int c = lane & 7;
#pragma unroll
    for (int j = 0; j < 4; ++j) { const int n = (lane >> 3) + 8 * j; const LAS float* s = scr + (8 * c) * 33 + n;
        u32x4 o; o.x = pk_bf16(s[0 * 33], s[1 * 33]); o.y = pk_bf16(s[2 * 33], s[3 * 33]); o.z = pk_bf16(s[4 * 33], s[5 * 33]); o.w = pk_bf16(s[6 * 33], s[7 * 33]);
        *(GAS u32x4*)(WT + (size_t)(drow0 + n) * K + k0 + 8 * c) = o; }
    asm volatile("s_waitcnt lgkmcnt(0)" ::: "memory");
}

struct Args { const float* in[31]; float* out; unsigned char* ws; int ph_lo, ph_hi; };

typedef const __attribute__((address_space(4))) char* kargp0_t;
#define A_IN(k) ((const float*)(*(const unsigned long long volatile __attribute__((address_space(4)))*)((kargp0_t)__builtin_amdgcn_kernarg_segment_ptr() + 8 * (k))))
DI void p0_phase(unsigned char* ws  , LAS unsigned char* lds, int gw, int NGW, int wave, int lane, int gtid, int gthreads) {
    LAS float* scr = (LAS float*)(lds + wave * 16384);
    constexpr int I_FF = 16 * 88;
    constexpr int I_IN = 16 * 56, I_O = 16 * 32, I_QKV = 16 * 96;
    constexpr int NITEMS = 12 * I_FF + I_IN + 2 * I_O + I_QKV;
    for (int it = gw; it < NITEMS; it += NGW) {
        int r = it; bool done = false;
#pragma unroll
        for (int f = 0; f < 4; ++f) {
            const int nf = (f == 0 ? 2 : (f == 1 ? 14 : (f == 2 ? 18 : 26)));
            bf16_t* wgu = (bf16_t*)(ws + WS_WGU + f * WGU_STRIDE); bf16_t* wd = (bf16_t*)(ws + WS_WD + f * WD_STRIDE);
            if (!done && r < I_FF) { p0_transpose_item(A_IN(nf + 1), DM, DFF, wgu, 1, scr, r, lane, A_IN(nf)); done = true; } r -= I_FF;
            if (!done && r >= 0 && r < I_FF) { p0_transpose_item(A_IN(nf + 2), DM, DFF, wgu, 2, scr, r, lane, A_IN(nf)); done = true; } r -= I_FF;
            if (!done && r >= 0 && r < I_FF) { p0_transpose_item(A_IN(nf + 3), DFF, DM, wd, 0, scr, r, lane); done = true; } r -= I_FF;
        }
        if (!done && r >= 0 && r < I_IN) { p0_transpose_item(A_IN(7), DM, ZW, (bf16_t*)(ws + WS_WIN), 0, scr, r, lane, A_IN(6)); done = true; } r -= I_IN;
        if (!done && r >= 0 && r < I_O) { p0_transpose_item(A_IN(13), DM, DM, (bf16_t*)(ws + WS_WOUT0), 0, scr, r, lane); done = true; } r -= I_O;
        if (!done && r >= 0 && r < I_QKV) { p0_transpose_item(A_IN(23), DM, QKVW, (bf16_t*)(ws + WS_WQKV), 0, scr, r, lane, A_IN(22)); done = true; } r -= I_QKV;
        if (!done && r >= 0 && r < I_O) { p0_transpose_item(A_IN(25), DM, DM, (bf16_t*)(ws + WS_WOUT1), 0, scr, r, lane); done = true; }
    }
    float* rc = (float*)(ws + WS_ROPE_C); float* rs = (float*)(ws + WS_ROPE_S);
    for (int i = gtid; i < 4096 * 8; i += gthreads) {
        const int pos = i >> 3, k = i & 7;
        const float inv = powf(500000.0f, -(float)(2 * k) / 16.0f);
        const float ang = (float)pos * inv;
        ((GAS float*)rc)[i] = cosf(ang); ((GAS float*)rs)[i] = sinf(ang);
    }
    bf16_t* sw = (bf16_t*)(ws + WS_SGUW);
    for (int i = gtid; i < 4 * 128 * 128 / 2; i += gthreads) { const f32x2 v = ((const GAS f32x2*)A_IN(10))[i]; ((GAS unsigned*)sw)[i] = pk_bf16(v.x, v.y); }
}

DI void convert_phase(const float* xin0, const float* xin1, bf16_t* XB, float* SSP, int gw, int NGW, int lane) {
    for (int m = gw; m < MT; m += NGW) {
        const GAS f32x4* xr = (const GAS f32x4*)(m < MH ? xin0 + (size_t)m * DM : xin1 + (size_t)(m - MH) * DM) + lane;
        f32x4 v[4]; float s = 0.f;
#pragma unroll
        for (int j = 0; j < 4; ++j) { v[j] = xr[64 * j]; s += (v[j].x * v[j].x + v[j].y * v[j].y) + (v[j].z * v[j].z + v[j].w * v[j].w); }
        s = wave_sum(s);
        bf16_t* ob = XB + (size_t)(m >> 7) * 32 * 4096 + (m & 127) * 32;
#pragma unroll
        for (int j = 0; j < 4; ++j) { const int cidx = 4 * lane + 256 * j; u32x2 w; w.x = pk_bf16(v[j].x, v[j].y); w.y = pk_bf16(v[j].z, v[j].w); *(GAS u32x2*)(ob + (size_t)(cidx >> 5) * 4096 + (cidx & 31)) = w; }
        if (lane < 16) ((GAS float*)SSP)[(size_t)m * 16 + lane] = lane == 0 ? s : 0.f;
    }
}
DI void final_norm_phase(const bf16_t* XB, float* out, const float* SSP, const float* gain, int gw, int NGW, int lane) {
    f32x4 g[4];
#pragma unroll
    for (int j = 0; j < 4; ++j) g[j] = ((const GAS f32x4*)gain)[lane + 64 * j];
    for (int m = gw; m < MT; m += NGW) {
        const bf16_t* xb = XB + (size_t)(m >> 7) * 32 * 4096 + (m & 127) * 32;
        u32x2 v[4];
#pragma unroll
        for (int j = 0; j < 4; ++j) { const int cidx = 4 * lane + 256 * j; v[j] = *(const GAS u32x2*)(xb + (size_t)(cidx >> 5) * 4096 + (cidx & 31)); }
        float s = ((const GAS float*)SSP)[(size_t)m * 16 + (lane & 15)];
        s += __shfl_xor(s, 1); s += __shfl_xor(s, 2); s += __shfl_xor(s, 4); s += __shfl_xor(s, 8);
        const float r = 1.0f / sqrtf(s * (1.f / DM) + EPS);
        GAS f32x4* o = (GAS f32x4*)(out + (size_t)m * DM) + lane;
#pragma unroll
        for (int j = 0; j < 4; ++j) { const f32x4 x = {bflo(v[j].x), bfhi(v[j].x), bflo(v[j].y), bfhi(v[j].y)}; o[64 * j] = x * r * g[j]; }
    }
}
template <class Sched> DI void precompute_rl(LAS unsigned char* lds, const Sched& S, const float* SSP, int tid) {
    LAS float* rl = (LAS float*)(lds + RL_OFF);
#pragma unroll 1
    for (int i0 = 0; i0 < RL_UNITS; i0 += 8) {
        f32x4 a[8], b[8]; bool ok[8];
#pragma unroll
        for (int j = 0; j < 8; ++j) {
            pg8::Unit u; ok[j] = S.next(i0 + j, u);
            if (ok[j]) { const GAS f32x4* p = (const GAS f32x4*)(SSP + (size_t)(u.pm * 256 + (tid >> 1)) * 16 + 8 * (tid & 1)); a[j] = p[0]; b[j] = p[1]; }
        }
        if (!ok[0]) break;
#pragma unroll
        for (int j = 0; j < 8; ++j) {
            if (ok[j]) {
                float s = (a[j].x + a[j].y) + (a[j].z + a[j].w) + (b[j].x + b[j].y) + (b[j].z + b[j].w);
                s += __shfl_xor(s, 1);
                if (!(tid & 1)) rl[(i0 + j) * 256 + (tid >> 1)] = 1.0f / sqrtf(s * (1.f / DM) + EPS);
            }
        }
    }
    __syncthreads();
}

template <class SF>
DI void attn_tile(f32x16& o0, f32x16& o1, float& m, float& l, const bf16x8 (&q)[4], LAS const char* Kt, LAS const char* Vt, int lane, SF sfun) {
    const int r = lane & 31, h = lane >> 5;
    f32x16 st;
#pragma unroll
    for (int i = 0; i < 16; ++i) st[i] = 0.f;
    {
        LAS const char* kp = Kt + r * 128; const int sw = r & 7;
#pragma unroll
        for (int s = 0; s < 4; ++s) { const bf16x8 kf = *(LAS const bf16x8*)(kp + (((2 * s + h) ^ sw) << 4)); st = MFMA32(kf, q[s], st); }
    }
    float mx = -1e30f;
#pragma unroll
    for (int i = 0; i < 16; ++i) { st[i] = sfun(i, st[i]); mx = fmaxf(mx, st[i]); }
    mx = fmaxf(mx, __shfl_xor(mx, 32));
    if (__any(mx > m + 8.0f)) {
        const float mn = fmaxf(m, mx), alpha = __builtin_amdgcn_exp2f(m - mn); m = mn;
        l *= alpha;
#pragma unroll
        for (int i = 0; i < 16; ++i) { o0[i] *= alpha; o1[i] *= alpha; }
    }
    st = st - m;
#pragma unroll
    for (int i = 0; i < 16; ++i) st[i] = __builtin_amdgcn_exp2f(st[i]);
    l += hsum16(st);
    const int blk = (lane >> 4) & 1, q4 = (lane & 15) >> 2, p = lane & 3, rsw = 4 * h + q4;
#pragma unroll
    for (int s = 0; s < 2; ++s) {
        const bf16x8 pb = pack8(st, s);
        LAS const char* vrow = Vt + (16 * s + 4 * h + q4) * 128 + 8 * (p & 1);
#pragma unroll
        for (int dt = 0; dt < 2; ++dt) {
            const int ch = ((4 * dt + 2 * blk + (p >> 1)) ^ rsw) << 4;
            const s16x4 lo = tr_read(vrow + ch), hi = tr_read(vrow + 8 * 128 + ch);
            const bf16x8 vf = __builtin_shufflevector(lo, hi, 0, 1, 2, 3, 4, 5, 6, 7);
            if (dt == 0) o0 = MFMA32(vf, pb, o0); else o1 = MFMA32(vf, pb, o1);
        }
    }
}
template <class SF0, class SF1>
DI void attn_tile2(f32x16& o0, f32x16& o1, float& m, float& l, const bf16x8 (&q)[4], LAS const char* K0, LAS const char* V0, LAS const char* K1, LAS const char* V1, int lane, SF0 f0, SF1 f1) {
    const int r = lane & 31, h = lane >> 5;
    f32x16 sa, sb;
#pragma unroll
    for (int i = 0; i < 16; ++i) { sa[i] = 0.f; sb[i] = 0.f; }
    {
        const int sw = r & 7; LAS const char* kp0 = K0 + r * 128; LAS const char* kp1 = K1 + r * 128;
#pragma unroll
        for (int s = 0; s < 4; ++s) {
            const int co = (((2 * s + h) ^ sw) << 4);
            const bf16x8 ka = *(LAS const bf16x8*)(kp0 + co), kb = *(LAS const bf16x8*)(kp1 + co);
            sa = MFMA32(ka, q[s], sa); sb = MFMA32(kb, q[s], sb);
        }
    }
    sa = f0(sa); sb = f1(sb);
    float mx = -1e30f;
#pragma unroll
    for (int i = 0; i < 16; ++i) mx = fmaxf(fmaxf(mx, sa[i]), sb[i]);
    mx = fmaxf(mx, __shfl_xor(mx, 32));
    if (__any(mx > m + 8.0f)) {
        const float mn = fmaxf(m, mx), alpha = __builtin_amdgcn_exp2f(m - mn); m = mn;
        l *= alpha;
#pragma unroll
        for (int i = 0; i < 16; ++i) { o0[i] *= alpha; o1[i] *= alpha; }
    }
    sa = sa - m; sb = sb - m;
#pragma unroll
    for (int i = 0; i < 16; ++i) { sa[i] = __builtin_amdgcn_exp2f(sa[i]); sb[i] = __builtin_amdgcn_exp2f(sb[i]); }
    l += hsum16(sa + sb);
    const int blk = (lane >> 4) & 1, q4 = (lane & 15) >> 2, p = lane & 3, rsw = 4 * h + q4;
#pragma unroll
    for (int s = 0; s < 2; ++s) {
        const bf16x8 fa = pack8(sa, s), fb = pack8(sb, s);
        const int ro = (16 * s + 4 * h + q4) * 128 + 8 * (p & 1);
#pragma unroll
        for (int dt = 0; dt < 2; ++dt) {
            const int ch = ((4 * dt + 2 * blk + (p >> 1)) ^ rsw) << 4;
            const s16x4 alo = tr_read(V0 + ro + ch), ahi = tr_read(V0 + ro + 8 * 128 + ch), blo = tr_read(V1 + ro + ch), bhi = tr_read(V1 + ro + 8 * 128 + ch);
            const bf16x8 vfa = __builtin_shufflevector(alo, ahi, 0, 1, 2, 3, 4, 5, 6, 7), vfb = __builtin_shufflevector(blo, bhi, 0, 1, 2, 3, 4, 5, 6, 7);
            if (dt == 0) { o0 = MFMA32(vfa, fa, o0); o0 = MFMA32(vfb, fb, o0); } else { o1 = MFMA32(vfa, fa, o1); o1 = MFMA32(vfb, fb, o1); }
        }
    }
}
DI void attn_store(const f32x16& o0, const f32x16& o1, float inv_l, bf16_t* orow  , int h) {
#pragma unroll
    for (int i4 = 0; i4 < 4; ++i4) {
        u32x2 w0, w1;
        w0.x = pk_bf16(o0[4 * i4] * inv_l, o0[4 * i4 + 1] * inv_l); w0.y = pk_bf16(o0[4 * i4 + 2] * inv_l, o0[4 * i4 + 3] * inv_l);
        w1.x = pk_bf16(o1[4 * i4] * inv_l, o1[4 * i4 + 1] * inv_l); w1.y = pk_bf16(o1[4 * i4 + 2] * inv_l, o1[4 * i4 + 3] * inv_l);
        *(GAS u32x2*)(orow + 8 * i4 + 4 * h) = w0; *(GAS u32x2*)(orow + 4096 + 8 * i4 + 4 * h) = w1;
    }
}
DI void rope16(u32x4& a, u32x4& b, const float* rc, const float* rs, int pos) {
    const f32x4 c0 = *(const GAS f32x4*)(rc + pos * 8), c1 = *(const GAS f32x4*)(rc + pos * 8 + 4), s0 = *(const GAS f32x4*)(rs + pos * 8), s1 = *(const GAS f32x4*)(rs + pos * 8 + 4);
    const float cs[8] = {c0.x, c0.y, c0.z, c0.w, c1.x, c1.y, c1.z, c1.w}, sn[8] = {s0.x, s0.y, s0.z, s0.w, s1.x, s1.y, s1.z, s1.w};
    const unsigned av[4] = {a.x, a.y, a.z, a.w}, bv[4] = {b.x, b.y, b.z, b.w};
    unsigned ao[4], bo[4];
#pragma unroll
    for (int j = 0; j < 4; ++j) {
        const float x1l = bflo(av[j]), x1h = bfhi(av[j]), x2l = bflo(bv[j]), x2h = bfhi(bv[j]);
        ao[j] = pk_bf16(x1l * cs[2 * j] - x2l * sn[2 * j], x1h * cs[2 * j + 1] - x2h * sn[2 * j + 1]);
        bo[j] = pk_bf16(x2l * cs[2 * j] + x1l * sn[2 * j], x2h * cs[2 * j + 1] + x1h * sn[2 * j + 1]);
    }
    a = (u32x4){ao[0], ao[1], ao[2], ao[3]}; b = (u32x4){bo[0], bo[1], bo[2], bo[3]};
}

DI void swa_unit(LAS unsigned char* ldsu, const bf16_t* Z, bf16_t* AB, const float* rc, const float* rs, const float* sink, int rowbase, int b, int n, int g, int L, int tid) {
    LAS char* lds = (LAS char*)ldsu;
    const int lane = tid & 63, w = tid >> 6, r = lane & 31, h = lane >> 5;
    LAS char* Ks = lds; LAS char* Vs = lds + 49152;
    for (int it = tid; it < 1536; it += NTHREADS) {
        const int kr = it >> 2, seg = it & 3, pos = 128 * (n - 1) + kr;
        if (pos < 0 || pos >= L) continue;
        const size_t zr = (size_t)(rowbase + b * L + pos);
        const bf16_t* kp = Z + toff(zr, 1536 + 64 * g + 16 * seg, ZW / 32); const bf16_t* vp = Z + toff(zr, 1664 + 64 * g + 16 * seg, ZW / 32);
        u32x4 k0 = *(const GAS u32x4*)kp, k1 = *(const GAS u32x4*)(kp + 8);
        const u32x4 v0 = *(const GAS u32x4*)vp, v1 = *(const GAS u32x4*)(vp + 8);
        if (seg == 0) rope16(k0, k1, rc, rs, pos);
        const int sw = kr & 7, c0 = ((2 * seg) ^ sw) << 4, c1 = ((2 * seg + 1) ^ sw) << 4;
        *(LAS u32x4*)(Ks + kr * 128 + c0) = k0; *(LAS u32x4*)(Ks + kr * 128 + c1) = k1;
        *(LAS u32x4*)(Vs + kr * 128 + c0) = v0; *(LAS u32x4*)(Vs + kr * 128 + c1) = v1;
    }
    __syncthreads();
#pragma unroll 1
    for (int qq = 0; qq < 2; ++qq) {
        const int qi = 2 * w + qq, r4 = qi >> 2, qt = qi & 3, head = 4 * g + r4;
        const int qpos = 128 * n + 32 * qt + r;
        const size_t qr_ = (size_t)(rowbase + b * L + qpos);
        bf16x8 q[4];
#pragma unroll
        for (int s = 0; s < 4; ++s) q[s] = *(const GAS bf16x8*)(Z + toff(qr_, 1024 + 64 * head + 16 * s + 8 * h, ZW / 32));
        {
            const u32x4 mine = __builtin_bit_cast(u32x4, q[0]);
            u32x4 oth; oth.x = __shfl_xor(mine.x, 32); oth.y = __shfl_xor(mine.y, 32); oth.z = __shfl_xor(mine.z, 32); oth.w = __shfl_xor(mine.w, 32);
            const f32x4 c0 = *(const GAS f32x4*)(rc + qpos * 8), c1 = *(const GAS f32x4*)(rc + qpos * 8 + 4), s0 = *(const GAS f32x4*)(rs + qpos * 8), s1 = *(const GAS f32x4*)(rs + qpos * 8 + 4);
            const float cs[8] = {c0.x, c0.y, c0.z, c0.w, c1.x, c1.y, c1.z, c1.w}, sn[8] = {s0.x, s0.y, s0.z, s0.w, s1.x, s1.y, s1.z, s1.w};
            const unsigned mv[4] = {mine.x, mine.y, mine.z, mine.w}, ov[4] = {oth.x, oth.y, oth.z, oth.w};
            const float sg = h ? 1.f : -1.f; unsigned res[4];
#pragma unroll
            for (int j = 0; j < 4; ++j) res[j] = pk_bf16(bflo(mv[j]) * cs[2 * j] + sg * bflo(ov[j]) * sn[2 * j], bfhi(mv[j]) * cs[2 * j + 1] + sg * bfhi(ov[j]) * sn[2 * j + 1]);
            q[0] = __builtin_bit_cast(bf16x8, (u32x4){res[0], res[1], res[2], res[3]});
        }
        f32x16 o0, o1;
#pragma unroll
        for (int i = 0; i < 16; ++i) { o0[i] = 0.f; o1[i] = 0.f; }
        float m = -1e30f, l = 0.f;
        {
            const int nb = L / 128;
            const int dk_lo = n == 0 ? (4 - qt > 0 ? 4 - qt : 0) : 0, dk_hi = n == nb - 1 ? (7 - qt < 8 ? 7 - qt : 8) : 8;
            if (dk_lo == 0) attn_tile(o0, o1, m, l, q, Ks + qt * 4096, Vs + qt * 4096, lane, [&](int i, float s) { return crow(i, h) >= r ? s * C2 : -1e30f; });
            int d = dk_lo > 1 ? dk_lo : 1; const int de = dk_hi < 7 ? dk_hi : 7;
#pragma unroll 1
            for (; d + 1 <= de; d += 2) { const int kt = qt + d;
                attn_tile2(o0, o1, m, l, q, Ks + kt * 4096, Vs + kt * 4096, Ks + (kt + 1) * 4096, Vs + (kt + 1) * 4096, lane, [&](f32x16 s) { return s * C2; }, [&](f32x16 s) { return s * C2; }); }
            if (d <= de) attn_tile(o0, o1, m, l, q, Ks + (qt + d) * 4096, Vs + (qt + d) * 4096, lane, [&](int i, float s) { return s * C2; });
            if (dk_hi == 8) attn_tile(o0, o1, m, l, q, Ks + (qt + 8) * 4096, Vs + (qt + 8) * 4096, lane, [&](int i, float s) { return crow(i, h) <= r ? s * C2 : -1e30f; });
        }
        const float lt = l + __shfl_xor(l, 32) + __builtin_amdgcn_exp2f(((const GAS float*)sink)[head] * LOG2E - m);
        attn_store(o0, o1, 1.0f / lt, AB + toff(qr_, 512 + 64 * head, DM / 32), h);
    }
    __syncthreads();
}

constexpr int SGU_PITCH = 1040;
DI void sgu_unit(LAS unsigned char* ldsu, const bf16_t* Z, bf16_t* AB, const bf16_t* SW, const float* sgu_b, const float* ln_g, const float* ln_b, int t0, int tid) {
    LAS char* lds = (LAS char*)ldsu;
    const int lane = tid & 63, w = tid >> 6, r = lane & 31, h = lane >> 5;
    const int g = w >> 1, chf = w & 1;
    const bf16_t* wg = SW + (size_t)g * 128 * 128 + (size_t)r * 128 + 8 * h;
    {
        const f32x4 g0 = *(const GAS f32x4*)(ln_g + 8 * lane), g1 = *(const GAS f32x4*)(ln_g + 8 * lane + 4), b0 = *(const GAS f32x4*)(ln_b + 8 * lane), b1 = *(const GAS f32x4*)(ln_b + 8 * lane + 4);
#pragma unroll 1
        for (int tb = 0; tb < 16; tb += 8) {
        u32x4 zv[8];
#pragma unroll
        for (int t = 0; t < 8; ++t) zv[t] = *(const GAS u32x4*)(Z + toff((size_t)(t0 + 16 * w + tb + t), 512 + 8 * lane, ZW / 32));
#pragma unroll
        for (int t = 0; t < 8; ++t) {
            const int tok = 16 * w + tb + t;
            f32x4 x0 = {bflo(zv[t].x), bfhi(zv[t].x), bflo(zv[t].y), bfhi(zv[t].y)}, x1 = {bflo(zv[t].z), bfhi(zv[t].z), bflo(zv[t].w), bfhi(zv[t].w)};
            const float mu = wave_sum((x0.x + x0.y) + (x0.z + x0.w) + (x1.x + x1.y) + (x1.z + x1.w)) * (1.f / 512.f);
            x0 = x0 - mu; x1 = x1 - mu;
            const float var = wave_sum((x0.x * x0.x + x0.y * x0.y) + (x0.z * x0.z + x0.w * x0.w) + (x1.x * x1.x + x1.y * x1.y) + (x1.z * x1.z + x1.w * x1.w)) * (1.f / 512.f);
            const float rstd = 1.0f / sqrtf(var + EPS);
            const f32x4 y0 = x0 * rstd * g0 + b0, y1 = x1 * rstd * g1 + b1;
            u32x4 o; o.x = pk_bf16(y0.x, y0.y); o.y = pk_bf16(y0.z, y0.w); o.z = pk_bf16(y1.x, y1.y); o.w = pk_bf16(y1.z, y1.w);
            *(LAS u32x4*)(lds + tok * SGU_PITCH + 16 * lane) = o;
        }
        }
    }
    __syncthreads();
    const int blk = (lane >> 4) & 1, q4 = (lane & 15) >> 2, p = lane & 3;
    LAS const char* abase = lds + (8 * h + q4) * SGU_PITCH + (128 * g + 64 * chf + 16 * blk) * 2 + 8 * p;
#pragma unroll
    for (int it = 0; it < 4; ++it) {
        const int tok = 32 * it + r;
        const bf16_t* urow = Z + toff((size_t)(t0 + tok), 128 * g + 64 * chf, ZW / 32) + 4 * h;
        u32x2 uu[2][4];
#pragma unroll
        for (int ct = 0; ct < 2; ++ct)
#pragma unroll
            for (int i4 = 0; i4 < 4; ++i4) uu[ct][i4] = *(const GAS u32x2*)(urow + 4096 * ct + 8 * i4);
        const float bias = ((const GAS float*)sgu_b)[g * 128 + tok];
        bf16x8 bcur[8];
#pragma unroll
        for (int s = 0; s < 8; ++s) bcur[s] = *(const GAS bf16x8*)(wg + (size_t)(32 * it) * 128 + 16 * s);
        f32x16 acc[2];
#pragma unroll
        for (int ct = 0; ct < 2; ++ct)
#pragma unroll
            for (int i = 0; i < 16; ++i) acc[ct][i] = 0.f;
#pragma unroll
        for (int s = 0; s < 8; ++s) {
#pragma unroll
            for (int ct = 0; ct < 2; ++ct) {
                LAS const char* base = abase + 16 * s * SGU_PITCH + 64 * ct;
                const s16x4 lo = tr_read(base), hi = tr_read(base + 4 * SGU_PITCH);
                const bf16x8 af = __builtin_shufflevector(lo, hi, 0, 1, 2, 3, 4, 5, 6, 7);
                acc[ct] = MFMA32(af, bcur[s], acc[ct]);
            }
        }
        bf16_t* orow = AB + toff((size_t)(t0 + tok), 128 * g + 64 * chf, DM / 32) + 4 * h;
#pragma unroll
        for (int ct = 0; ct < 2; ++ct)
#pragma unroll
            for (int i4 = 0; i4 < 4; ++i4) {
                const u32x2 u2 = uu[ct][i4];
                u32x2 o; o.x = pk_bf16(bflo(u2.x) * (acc[ct][4 * i4] + bias), bfhi(u2.x) * (acc[ct][4 * i4 + 1] + bias));
                o.y = pk_bf16(bflo(u2.y) * (acc[ct][4 * i4 + 2] + bias), bfhi(u2.y) * (acc[ct][4 * i4 + 3] + bias));
                *(GAS u32x2*)(orow + 4096 * ct + 8 * i4) = o;
            }
    }
    __syncthreads();
}

DI void na_unit(LAS unsigned char* ldsu, bf16_t* QO  , const bf16_t* KV  , const float* rpb, int b, int hh, int rg, int L, int tid) {
    LAS char* lds = (LAS char*)ldsu;
    const int lane = tid & 63, w = tid >> 6, r = lane & 31, h = lane >> 5;
    const int rows = L / 64, r0 = 4 * rg;
    const int lo = clampi(r0 - 4, 0, rows - 8), hiE = clampi(r0 - 1, 0, rows - 8) + 8;
    LAS float* rpbL = (LAS float*)(lds + 65536);
    for (int i = tid; i < 15 * 128; i += NTHREADS) { const int dr = i >> 7, dc = (i & 127) - 48; rpbL[i] = (dc >= 0 && dc < 31) ? ((const GAS float*)rpb)[hh * 465 + dr * 31 + dc] * LOG2E : 0.f; }
    const int cg = w & 3, qrA = r0 + 2 * (w >> 2);
    const int qr = qrA + (r >> 4), c = 16 * cg + (r & 15), rsb = clampi(qr - 4, 0, rows - 8), cs = clampi(c - 8, 0, 48);
    const int cs0 = clampi(16 * cg - 8, 0, 32), rsA = clampi(qrA - 4, 0, rows - 8), rsB = clampi(qrA - 3, 0, rows - 8);
    const size_t tokq = (size_t)b * L + 64 * qr + c;
    bf16x8 q[4];
#pragma unroll
    for (int s = 0; s < 4; ++s) q[s] = *(const GAS bf16x8*)(QO + toff(tokq, 64 * hh + 16 * s + 8 * h, DM / 32));
    f32x16 o0, o1;
#pragma unroll
    for (int i = 0; i < 16; ++i) { o0[i] = 0.f; o1[i] = 0.f; }
    float m = -1e30f, l = 0.f;
    f32x16 madd;
#pragma unroll
    for (int i = 0; i < 16; ++i) { const int kcol = cs0 + crow(i, h); madd[i] = (kcol >= cs && kcol < cs + 16) ? 0.f : -1e30f; }
    const int kc = tid >> 3, chunk = tid & 7;
    constexpr int KVW = 2048;
    (void)KVW;
#define NA_KOFF(row_) toff((size_t)b * L + 64 * (row_) + kc, 64 * hh + 8 * chunk, 64)
    const int stoff = kc * 128 + ((chunk ^ (kc & 7)) << 4);
    u32x4 kreg[4], vreg[4];
#pragma unroll
    for (int j = 0; j < 4; ++j) if (lo + j < hiE) { const bf16_t* kp_ = KV + NA_KOFF(lo + j); kreg[j] = *(const GAS u32x4*)kp_; vreg[j] = *(const GAS u32x4*)(kp_ + 131072); }
    int cur = 0;
#pragma unroll 1
    for (int base = lo; base < hiE; base += 4) {
#pragma unroll
        for (int j = 0; j < 4; j += 2) {
            const int kr = base + j;
            if (kr < hiE) {
                LAS char* Kb = lds + cur * 32768; LAS char* Vb = Kb + 8192;
                *(LAS u32x4*)(Kb + stoff) = kreg[j]; *(LAS u32x4*)(Vb + stoff) = vreg[j];
                if (kr + 1 < hiE) { *(LAS u32x4*)(Kb + 16384 + stoff) = kreg[j + 1]; *(LAS u32x4*)(Vb + 16384 + stoff) = vreg[j + 1]; }
                LDS_BARRIER();
                if (kr + 4 < hiE) { const bf16_t* kp_ = KV + NA_KOFF(kr + 4); kreg[j] = *(const GAS u32x4*)kp_; vreg[j] = *(const GAS u32x4*)(kp_ + 131072); }
                if (kr + 5 < hiE) { const bf16_t* kp_ = KV + NA_KOFF(kr + 5); kreg[j + 1] = *(const GAS u32x4*)kp_; vreg[j + 1] = *(const GAS u32x4*)(kp_ + 131072); }
                if (kr + 1 >= rsA && kr < rsB + 8) {
                    LAS const float* brow0 = rpbL + clampi(kr - qr + 7, 0, 14) * 128 + 63 - c + cs0 + 4 * h;
                    LAS const float* brow1 = rpbL + clampi(kr + 1 - qr + 7, 0, 14) * 128 + 63 - c + cs0 + 4 * h;
                    const float radd0 = (kr >= rsb && kr < rsb + 8) ? 0.f : -1e30f, radd1 = (kr + 1 >= rsb && kr + 1 < rsb + 8) ? 0.f : -1e30f;
                    attn_tile2(o0, o1, m, l, q, Kb + cs0 * 128, Vb + cs0 * 128, Kb + 16384 + cs0 * 128, Vb + 16384 + cs0 * 128, lane,
                        [&](f32x16 s) { f32x16 bv;
#pragma unroll
                            for (int i = 0; i < 16; ++i) bv[i] = brow0[(i & 3) + 8 * (i >> 2)];
                            return s * C2 + (bv + (madd + radd0)); },
                        [&](f32x16 s) { f32x16 bv;
#pragma unroll
                            for (int i = 0; i < 16; ++i) bv[i] = brow1[(i & 3) + 8 * (i >> 2)];
                            return s * C2 + (bv + (madd + radd1)); });
                }
                cur ^= 1;
            }
        }
    }
    const float lt = l + __shfl_xor(l, 32);
    attn_store(o0, o1, 1.0f / lt, QO + toff(tokq, 64 * hh, DM / 32), h);
    __syncthreads();
}

#define XB_TMO      128
#define XB_XCNT(j)  (256  + 64 * (j))
#define XB_XSUB(j)  (1280 + 64 * (j))
#define XB_XGEN(j)  (2304 + 64 * (j))
#define XB_TOP      3328
#define XB_TOPGEN   3392
#define XCD_BAR_WORDS 3456
#define XB_SPIN_CAP (1u << 18)

__device__ __forceinline__ unsigned xb_ld(unsigned* p)              { return __hip_atomic_load(p, __ATOMIC_RELAXED, __HIP_MEMORY_SCOPE_AGENT); }
__device__ __forceinline__ unsigned xb_add(unsigned* p, unsigned v) { return __hip_atomic_fetch_add(p, v, __ATOMIC_RELAXED, __HIP_MEMORY_SCOPE_AGENT); }
__device__ __forceinline__ unsigned xb_xcc_id() { return (unsigned)__builtin_amdgcn_s_getreg((3 << 11) | 20) & 0xFu; }
#define XB_SPIN(cond, bar) do { unsigned _sp = 0; while (cond) { __builtin_amdgcn_s_sleep(1); \
    if ((++_sp & 255u) == 0u) { if (xb_ld(&(bar)[XB_TMO])) break; if (_sp > XB_SPIN_CAP) { atomicAdd(&(bar)[XB_TMO], 1u); break; } } } } while (0)

struct XcdBarrier {
    unsigned* bar; unsigned x;
    volatile LAS unsigned* st;
};

__device__ __forceinline__ XcdBarrier xcd_barrier_post(unsigned* bar, volatile LAS unsigned* st) {
    XcdBarrier b; b.bar = bar; b.x = xb_xcc_id(); b.st = st;
    if (threadIdx.x == 0) (void)xb_add(&bar[XB_XCNT(b.x)], 1u);
    return b;
}
__device__ __forceinline__ void xcd_barrier_complete(unsigned* bar, unsigned x, unsigned& nloc, unsigned& nx) {
    const unsigned G = gridDim.x * gridDim.y * gridDim.z;
    unsigned sum, cnt, mine, sp = 0u;
    for (;;) {
        sum = 0u; cnt = 0u; mine = 0u;
#pragma unroll
        for (unsigned j = 0; j < 16; ++j) { const unsigned c = xb_ld(&bar[XB_XCNT(j)]); sum += c; cnt += (c > 0u) ? 1u : 0u; mine = (j == x) ? c : mine; }
        if (sum == G) break;
        __builtin_amdgcn_s_sleep(1);
        if ((++sp & 255u) == 0u) { if (xb_ld(&bar[XB_TMO])) break; if (sp > XB_SPIN_CAP) { atomicAdd(&bar[XB_TMO], 1u); break; } }
    }
    nloc = mine > 0u ? mine : 1u; nx = cnt > 0u ? cnt : 1u;
}

__device__ __forceinline__ void xcd_barrier(const XcdBarrier& b) {
    asm volatile("s_waitcnt vmcnt(0)" ::: "memory");
    __syncthreads();
    if (threadIdx.x == 0) {
        unsigned* bar = b.bar;
        __builtin_amdgcn_s_waitcnt(0);
        unsigned nloc = b.st[0], nx = b.st[1];
        if (nloc == 0u) { xcd_barrier_complete(bar, b.x, nloc, nx); b.st[0] = nloc; b.st[1] = nx; }
        const unsigned old = xb_add(&bar[XB_XSUB(b.x)], 1u);
        const unsigned gen = old / nloc;
        if (old + 1u == (gen + 1u) * nloc) {
            __builtin_amdgcn_fence(__ATOMIC_RELEASE, "agent");
            asm volatile("s_waitcnt vmcnt(0)" ::: "memory");
            const unsigned og = xb_add(&bar[XB_TOP], 1u);
            const unsigned tg = og / nx;
            if (og + 1u == (tg + 1u) * nx) xb_add(&bar[XB_TOPGEN], 1u);
            else XB_SPIN(xb_ld(&bar[XB_TOPGEN]) == tg, bar);
            __builtin_amdgcn_fence(__ATOMIC_ACQUIRE, "agent");
            xb_add(&bar[XB_XGEN(b.x)], 1u);
            asm volatile("s_waitcnt vmcnt(0)" ::: "memory");
        } else {
            XB_SPIN(xb_ld(&bar[XB_XGEN(b.x)]) == gen, bar);
            __builtin_amdgcn_fence(__ATOMIC_ACQUIRE, "agent");
            asm volatile("s_waitcnt vmcnt(0)" ::: "memory");
        }
    }
    __syncthreads();
}

constexpr size_t WS_BAR = WS_CTL + 16384;

typedef const __attribute__((address_space(4))) char* kargp_t;
#define KARG_PTR(T, k) ((T)(*(const unsigned long long volatile __attribute__((address_space(4)))*)((kargp_t)__builtin_amdgcn_kernarg_segment_ptr() + 8 * (k))))
#define KARG_IN(k) KARG_PTR(const float*, (k))
#define KARG_OUT() KARG_PTR(float*, 31)
#define KARG_WS() KARG_PTR(unsigned char*, 32)

__global__ void __launch_bounds__(NTHREADS, 2) fwd_megakernel(Args args) {
    extern __shared__ __attribute__((aligned(16))) unsigned char lds_raw[];
    LAS unsigned char* lds = (LAS unsigned char*)lds_raw;
    cg::grid_group grid = cg::this_grid();
    const int ph_lo = args.ph_lo, ph_hi = args.ph_hi;
    if (threadIdx.x < 16) ((LAS unsigned*)(lds + MISC_OFF))[threadIdx.x] = 0u;
    __syncthreads();
    XcdBarrier xbar; xbar.bar = (unsigned*)(KARG_WS() + WS_BAR); xbar.x = xb_xcc_id(); xbar.st = (volatile LAS unsigned*)(lds + MISC_OFF);
    if (threadIdx.x == 0) { const unsigned rank = xb_add(&xbar.bar[XB_XCNT(xbar.x)], 1u); xbar.st[4] = xbar.x + 8u * rank; xbar.st[5] = 0u; }
    __syncthreads();

#ifndef PROBE_DUP
#define PROBE_DUP 0u
#endif
    int rep = 0;
#pragma unroll 1
    for (int ph = ph_lo; ph < ph_hi;) {
        int tid = threadIdx.x; asm volatile("" : "+v"(tid));
        const int lane = tid & 63, wave = __builtin_amdgcn_readfirstlane(tid >> 6);
        int G = gridDim.x, bx = blockIdx.x; asm volatile("" : "+s"(G), "+s"(bx));
        const int bxg = __builtin_amdgcn_readfirstlane(xbar.st[5] ? (int)xbar.st[4] : bx);
        const int gw = bx * NWAVES + wave, NGW = G * NWAVES;
        unsigned char* ws = KARG_WS();
        unsigned char* wb = (unsigned char*)KARG_OUT();
        bf16_t* XN = (bf16_t*)(ws + WS_XN); bf16_t* BIG = (bf16_t*)(ws + WS_BIG); bf16_t* AB = (bf16_t*)(ws + WS_AB);
        float* SSP = (float*)(ws + WS_SSP);
        if (ph == 0) {
#ifndef NO_P0
            p0_phase(wb, lds, gw, NGW, wave, lane, bx * NTHREADS + tid, G * NTHREADS);
#endif
            convert_phase(KARG_IN(0), KARG_IN(1), XN, SSP, gw, NGW, lane);
        } else if (ph == 1 || ph == 6 || ph == 8 || ph == 16) {
#ifndef NO_G1
            const int f = ph == 1 ? 0 : ph == 6 ? 1 : ph == 8 ? 2 : 3;
            pg8::Gemm g{XN, (const bf16_t*)(wb + WS_WGU + f * WGU_STRIDE), MT, 2 * DFF, DM, 1}; pg8::StaticOrder S; S.init(MT, 2 * DFF, G, bxg);
            precompute_rl(lds, S, SSP, tid);
            pg8::EpiSwiGLU E{BIG, DFF, (const LAS float*)(lds + RL_OFF)};
            pg8::gemm_phase<pg8::EpiSwiGLU, pg8::StaticOrder, true, true>(lds, g, S, E);
#endif
        } else if (ph == 2 || ph == 7 || ph == 9 || ph == 17 || ph == 5 || ph == 12 || ph == 15) {
#ifndef NO_G2
            const bool ffn = !(ph == 5 || ph == 12 || ph == 15);
            const int f = ph == 2 ? 0 : ph == 7 ? 1 : ph == 9 ? 2 : 3;
            const int M = (ph == 12 || ph == 15) ? MH : MT;
            const size_t rb = ph == 15 ? (size_t)MH : 0;
            const bf16_t* A = ffn ? BIG : (ph == 5 ? AB : BIG  );
            const bf16_t* Bt = ffn ? (const bf16_t*)(wb + WS_WD + f * WD_STRIDE) : (const bf16_t*)(wb + (ph == 5 ? WS_WOUT0 : WS_WOUT1));
            pg8::Gemm g{A, Bt, M, DM, ffn ? DFF : DM, 1  }; pg8::StaticOrder S; S.init(M, DM, G, bxg);
            bf16_t* xb = XN + rb * DM;
            pg8::EpiResidual E{ffn ? 0.5f : 1.0f, xb, SSP + rb * 16, (PROBE_DUP != 0u && rep == 0 && ((PROBE_DUP >> ph) & 1u)) ? (bf16_t*)(ws + WS_END) : xb};
            pg8::gemm_phase<pg8::EpiResidual, pg8::StaticOrder, true, true>(lds, g, S, E);
#endif
        } else if (ph == 3 || ph == 10 || ph == 13) {
#ifndef NO_G3
            const int N = ph == 3 ? ZW : QKVW, M = ph == 3 ? MT : MH;
            const size_t rb = ph == 13 ? (size_t)MH : 0;
            pg8::Gemm g{XN + rb * DM, (const bf16_t*)(wb + (ph == 3 ? WS_WIN : WS_WQKV)), M, N, DM, 1}; pg8::StaticOrder S; S.init(M, N, G, bxg);
            precompute_rl(lds, S, SSP + rb * 16, tid);
            pg8::EpiBf16G E{BIG, ph == 3 ? ZW : DM, ph == 3 ? 4 : 0, (const LAS float*)(lds + RL_OFF), ph == 3 ? 1000 : 4, (bf16_t*)(ws + WS_KV), 2048};
            pg8::gemm_phase<pg8::EpiBf16G, pg8::StaticOrder, true, true>(lds, g, S, E);
#endif
        } else if (ph == 4) {
            const float* rc = (const float*)(wb + WS_ROPE_C); const float* rs = (const float*)(wb + WS_ROPE_S);
            constexpr int nchunks = MT / 128;
#ifndef NO_SWA
#pragma unroll 1
            for (int idx = bx; idx < 2 * nchunks; idx += G) {
                const int chunk = idx >> 1, g = idx & 1, hf = chunk >= 256, cl = chunk & 255, L = hf ? 2048 : 4096, nb = L / 128;
                swa_unit(lds, BIG, AB, rc, rs, KARG_IN(12), hf ? MH : 0, cl / nb, cl % nb, g, L, tid);
            }
#endif
#ifndef NO_SGU
#pragma unroll 1
            for (int idx = bx; idx < nchunks; idx += G) sgu_unit(lds, BIG, AB, (const bf16_t*)(wb + WS_SGUW), KARG_IN(11), KARG_IN(8), KARG_IN(9), idx * 128, tid);
#endif
        } else if (ph == 11 || ph == 14) {
#ifndef NO_NA
            const int L = ph == 14 ? 2048 : 4096;
            const int nrg = L / 256, nunits = (MH / L) * 16 * nrg;
#pragma unroll 1
            for (int idx = bx; idx < nunits; idx += G) { const int hh = idx & 15, rg = (idx >> 4) % nrg, b = (idx >> 4) / nrg; na_unit(lds, BIG, (const bf16_t*)(ws + WS_KV), KARG_IN(24), b, hh, rg, L, tid); }
#endif
        } else {
            final_norm_phase(XN, KARG_OUT(), SSP, KARG_IN(30), gw, NGW, lane);
        }
        if (PROBE_DUP != 0u && rep == 0 && ((PROBE_DUP >> ph) & 1u)) { rep = 1; xcd_barrier(xbar); continue; }
        rep = 0;
        if (ph + 1 < ph_hi) {
            if (ph == 0) {
                grid.sync();
                if (threadIdx.x == 0) {
                    const unsigned Gn = gridDim.x; unsigned even = (Gn % 8u == 0u) ? 1u : 0u;
                    for (unsigned j = 0; j < 16; ++j) { const unsigned cnt = xb_ld(&xbar.bar[XB_XCNT(j)]); if (cnt != (j < 8 ? Gn / 8u : 0u)) even = 0u; }
                    xbar.st[5] = even;
                }
                __syncthreads();
            } else xcd_barrier(xbar);
        }
        ++ph;
    }
}

extern "C" void kernel_launch(void* const* d_in, const int* in_sizes, int n_in, void* d_out, int out_size, void* d_ws, size_t ws_size, hipStream_t stream) {
    static int grid = 0;
    if (grid == 0) {
        if (n_in != 31 || out_size != MT * DM || ws_size < WS_END) { fprintf(stderr, "kernel_launch: unexpected shapes (n_in %d out %d ws %zu)\n", n_in, out_size, ws_size); grid = -1; return; }
        int dev = 0, cus = 0, per_cu = 0;
        hipGetDevice(&dev); hipDeviceGetAttribute(&cus, hipDeviceAttributeMultiprocessorCount, dev);
        if (hipFuncSetAttribute((const void*)fwd_megakernel, hipFuncAttributeMaxDynamicSharedMemorySize, LDS_BYTES) != hipSuccess) { fprintf(stderr, "kernel_launch: hipFuncSetAttribute failed\n"); grid = -1; return; }
        if (hipOccupancyMaxActiveBlocksPerMultiprocessor(&per_cu, (const void*)fwd_megakernel, NTHREADS, LDS_BYTES) != hipSuccess || per_cu < 1) { fprintf(stderr, "kernel_launch: occupancy query says %d\n", per_cu); per_cu = 1; }
        (void)hipGetLastError();
        grid = cus * per_cu;
        fprintf(stderr, "kernel_launch: grid %d (cus %d x %d)\n", grid, cus, per_cu);
    }
    if (grid < 0) return;
    if (hipMemsetAsync((char*)d_ws + WS_CTL, 0, 65536, stream) != hipSuccess) { fprintf(stderr, "kernel_launch: memset failed\n"); return; }
    Args a{};
    for (int i = 0; i < 31; ++i) a.in[i] = (const float*)d_in[i];
    a.out = (float*)d_out; a.ws = (unsigned char*)d_ws;
#if MK_SINGLE
    a.ph_lo = 0; a.ph_hi = NPHASES;
    void* kargs[] = {&a};
    hipError_t e = hipLaunchCooperativeKernel((const void*)fwd_megakernel, dim3(grid), dim3(NTHREADS), kargs, LDS_BYTES, stream);
    if (e != hipSuccess) fprintf(stderr, "cooperative launch failed: %s (grid %d)\n", hipGetErrorString(e), grid);
#else
    for (int ph = 0; ph < NPHASES; ++ph) {
        a.ph_lo = ph; a.ph_hi = ph + 1;
        hipLaunchKernelGGL(fwd_megakernel, dim3(grid), dim3(NTHREADS), LDS_BYTES, stream, a);
    }
#endif
}
```

```cpp
#include <hip/hip_runtime.h>
#include <hip/hip_cooperative_groups.h>
#include <cstdio>
#include <cstdint>
namespace cg = cooperative_groups;

#ifndef MK_SINGLE
#define MK_SINGLE 1
#endif

#define GAS __attribute__((address_space(1)))
namespace pg8 {
#define PG8_LAS __attribute__((address_space(3)))
typedef unsigned short bf16_t;
typedef short bf16x8 __attribute__((ext_vector_type(8)));
typedef float f32x4 __attribute__((ext_vector_type(4)));
typedef unsigned u32x4 __attribute__((ext_vector_type(4)));
constexpr int BM = 256, BK = 64, HALF = 128, HTB = HALF * BK * 2  , STAGE_BYTES = 8 * HTB, NXCD = 8, WGM = 8;

__host__ __device__ __forceinline__ int lds_byte(int r, int c) { const int st = (r >> 4) * 2 + (c >> 5), rr = r & 15, cc = c & 31, ob = rr * 64 + cc * 2; return st * 1024 + (ob ^ (((ob >> 9) & 1) << 5)); }
__host__ __device__ __forceinline__ void stage_rc(int b, int& R, int& C) { const int st = b / 1024, sb = b % 1024, swz = sb ^ (((sb >> 9) & 1) << 5); R = (st >> 1) * 16 + swz / 64; C = (st & 1) * 32 + (swz % 64) / 2; }
__host__ __device__ __forceinline__ int perm32(int rho) { const int n = rho >> 4, i = rho & 15; return 8 * (i >> 2) + 4 * n + (i & 3); }

struct Unit { int pm, pn; };
struct Gemm { const bf16_t* A; const bf16_t* Bt; int M, N, K; int tiledA; };

struct StaticOrder {
    int nM, nN, nwg, G, c;
    __host__ __device__ void init(int M, int N, int G_, int c_) { nM = M / BM; nN = N / BM; nwg = nM * nN; G = G_; c = c_; }
    __host__ __device__ bool next(int i, Unit& u) const {
        const long L = (long)i * G + c; if (L >= nwg) return false;
        int wgid = (int)L; { const int q = nwg / NXCD, r = nwg % NXCD, xcd = wgid % NXCD, off = wgid / NXCD; wgid = (xcd < r ? xcd * (q + 1) : r * (q + 1) + (xcd - r) * q) + off; }
        const int nig = WGM * nN, gid = wgid / nig, fm = gid * WGM, gsz = (nM - fm) < WGM ? (nM - fm) : WGM;
        u.pm = fm + ((wgid % nig) % gsz); u.pn = (wgid % nig) / gsz; return true;
    }
    __device__ __forceinline__ void a_ready(const Unit&) const {}
    __device__ __forceinline__ void done(const Unit&) const {}
};
__device__ __forceinline__ unsigned cvt_pk_bf16(float lo, float hi) { unsigned r; asm volatile("v_cvt_pk_bf16_f32 %0, %1, %2" : "=v"(r) : "v"(lo), "v"(hi)); return r; }
typedef float f32x2 __attribute__((ext_vector_type(2)));
__device__ __forceinline__ f32x2 gelu_pk(f32x2 v) {
    const f32x2 av = __builtin_elementwise_abs(v), d = av * 0.2316418882f + 1.0f;
    f32x2 t; t.x = __builtin_amdgcn_rcpf(d.x); t.y = __builtin_amdgcn_rcpf(d.y);
    f32x2 q = t * 0.5307027145f + (-0.7265760135f); q = q * t + 0.7107068705f; q = q * t + (-0.142248368f); q = q * t + 0.127414796f; q = q * t;
    const f32x2 s = (v * v) * (-0.72134752044f);
    f32x2 e; e.x = __builtin_amdgcn_exp2f(s.x); e.y = __builtin_amdgcn_exp2f(s.y);
    const f32x2 m = v * (q * e), r = v - m;
    f32x2 o; o.x = v.x < 0.f ? m.x : r.x; o.y = v.y < 0.f ? m.y : r.y; return o;
}

__device__ __forceinline__ unsigned pk_bf16(float lo, float hi) { typedef __bf16 bf2 __attribute__((ext_vector_type(2))); f32x2 v = {lo, hi}; bf2 b = __builtin_convertvector(v, bf2); return __builtin_bit_cast(unsigned, b); }
__device__ __forceinline__ float silu_mul(float g, float u) { return g * __builtin_amdgcn_rcpf(1.0f + __builtin_amdgcn_exp2f(-1.4426950408889634f * g)) * u; }

struct EpiSwiGLU {
    static constexpr bool PERM = true, AFTER_DRAIN = false;
    bf16_t* H; int ldh; const PG8_LAS float* rl;
    __device__ __forceinline__ void operator()(const f32x4 (&acc)[2][2][4][2], const Unit& u, int wr, int wc, int fr, int fq, int ui) const {
        const int row0 = u.pm * BM + wr * 64 + fr, col0 = u.pn * HALF + wc * 32 + 8 * fq;
        const PG8_LAS float* rp = rl + ui * 256 + wr * 64 + fr;
#pragma unroll
        for (int ai = 0; ai < 2; ++ai)
#pragma unroll
            for (int m = 0; m < 4; ++m) {
                bf16_t* p = H + ((size_t)(2 * u.pm + ai) * (ldh >> 5) + 4 * u.pn + wc) * 4096 + (wr * 64 + m * 16 + fr) * 32 + 8 * fq;
                const float rr = rp[ai * HALF + m * 16], c1 = -1.4426950408889634f * rr, c2 = rr * rr;
                f32x4 hv[2];
#pragma unroll
                for (int n = 0; n < 2; ++n) {
                    const f32x4 g = acc[ai][0][m][n], uu = acc[ai][1][m][n];
                    f32x4 e = g * c1;
                    e = (f32x4){__builtin_amdgcn_exp2f(e[0]), __builtin_amdgcn_exp2f(e[1]), __builtin_amdgcn_exp2f(e[2]), __builtin_amdgcn_exp2f(e[3])};
                    const f32x4 d = e + 1.0f;
                    const f32x4 r = {__builtin_amdgcn_rcpf(d[0]), __builtin_amdgcn_rcpf(d[1]), __builtin_amdgcn_rcpf(d[2]), __builtin_amdgcn_rcpf(d[3])};
                    hv[n] = (g * uu) * (r * c2);
                }
                u32x4 w;
                w.x = pk_bf16(hv[0][0], hv[0][1]); w.y = pk_bf16(hv[0][2], hv[0][3]); w.z = pk_bf16(hv[1][0], hv[1][1]); w.w = pk_bf16(hv[1][2], hv[1][3]);
                __builtin_nontemporal_store(w, (GAS u32x4*)p);
            }
    }
};
struct EpiResidual {
    static constexpr bool PERM = true, AFTER_DRAIN = false;
    float scale; bf16_t* XB; float* SSP; bf16_t* XBo;
    __device__ __forceinline__ void operator()(const f32x4 (&acc)[2][2][4][2], const Unit& u, int wr, int wc, int fr, int fq, int ui) const {
        const int row0 = u.pm * BM + wr * 64 + fr;
#pragma unroll
        for (int ai = 0; ai < 2; ++ai) {
            u32x4 xb[4][2];
#pragma unroll
            for (int m = 0; m < 4; ++m)
#pragma unroll
                for (int bj = 0; bj < 2; ++bj) xb[m][bj] = *(const GAS u32x4*)(XB + ((size_t)(2 * u.pm + ai) * 32 + 8 * u.pn + 4 * bj + wc) * 4096 + (wr * 64 + m * 16 + fr) * 32 + 8 * fq);
#pragma unroll
            for (int m = 0; m < 4; ++m) {
                const int row = row0 + ai * HALF + m * 16;
                float ss = 0.f;
#pragma unroll
                for (int bj = 0; bj < 2; ++bj) {
                    const u32x4 b = xb[m][bj];
                    const f32x4 a0 = {__builtin_bit_cast(float, b.x << 16), __builtin_bit_cast(float, b.x & 0xffff0000u), __builtin_bit_cast(float, b.y << 16), __builtin_bit_cast(float, b.y & 0xffff0000u)};
                    const f32x4 a1 = {__builtin_bit_cast(float, b.z << 16), __builtin_bit_cast(float, b.z & 0xffff0000u), __builtin_bit_cast(float, b.w << 16), __builtin_bit_cast(float, b.w & 0xffff0000u)};
                    const f32x4 o0 = a0 + acc[ai][bj][m][0] * scale, o1 = a1 + acc[ai][bj][m][1] * scale;
                    ss += (o0[0] * o0[0] + o0[1] * o0[1]) + (o0[2] * o0[2] + o0[3] * o0[3]) + (o1[0] * o1[0] + o1[1] * o1[1]) + (o1[2] * o1[2] + o1[3] * o1[3]);
                    u32x4 w; w.x = pk_bf16(o0[0], o0[1]); w.y = pk_bf16(o0[2], o0[3]); w.z = pk_bf16(o1[0], o1[1]); w.w = pk_bf16(o1[2], o1[3]);
                    *(GAS u32x4*)(XBo + ((size_t)(2 * u.pm + ai) * 32 + 8 * u.pn + 4 * bj + wc) * 4096 + (wr * 64 + m * 16 + fr) * 32 + 8 * fq) = w;
                }
                { const unsigned sb = __builtin_bit_cast(unsigned, ss); auto r16 = __builtin_amdgcn_permlane16_swap(sb, sb, false, false);
                  ss = __builtin_bit_cast(float, (unsigned)r16[0]) + __builtin_bit_cast(float, (unsigned)r16[1]);
                  const unsigned sc = __builtin_bit_cast(unsigned, ss); auto r32 = __builtin_amdgcn_permlane32_swap(sc, sc, false, false);
                  ss = __builtin_bit_cast(float, (unsigned)r32[0]) + __builtin_bit_cast(float, (unsigned)r32[1]); }
                if (fq == 0) ((GAS float*)SSP)[(size_t)row * 16 + u.pn * 4 + wc] = ss;
            }
        }
    }
};
struct EpiBf16G {
    static constexpr bool PERM = true, AFTER_DRAIN = false;
    bf16_t* O; int ldc; int gelu_tiles; const PG8_LAS float* rl; int split_tiles; bf16_t* O2; int ldc2;
    __device__ __forceinline__ void operator()(const f32x4 (&acc)[2][2][4][2], const Unit& u, int wr, int wc, int fr, int fq, int ui) const {
        const bool second = u.pn >= split_tiles;
        bf16_t* const Ob = second ? O2 : O; const int ld = second ? ldc2 : ldc;
        const int pnl = second ? u.pn - split_tiles : u.pn, nslab = ld >> 5;
        const PG8_LAS float* rp = rl + ui * 256 + wr * 64 + fr;
        const bool act = u.pn < gelu_tiles;
#pragma unroll
        for (int ai = 0; ai < 2; ++ai)
#pragma unroll
            for (int m = 0; m < 4; ++m) {
                bf16_t* rowp = Ob + ((size_t)(2 * u.pm + ai) * nslab + 8 * pnl + wc) * 4096 + (wr * 64 + m * 16 + fr) * 32 + 8 * fq;
                const float rr = rp[ai * HALF + m * 16];
#pragma unroll
                for (int bj = 0; bj < 2; ++bj) {
                    f32x4 v0 = acc[ai][bj][m][0] * rr, v1 = acc[ai][bj][m][1] * rr;
                    if (act) { f32x2 a = gelu_pk((f32x2){v0[0], v0[1]}), b = gelu_pk((f32x2){v0[2], v0[3]}), c = gelu_pk((f32x2){v1[0], v1[1]}), d = gelu_pk((f32x2){v1[2], v1[3]});
                        v0 = (f32x4){a.x, a.y, b.x, b.y}; v1 = (f32x4){c.x, c.y, d.x, d.y}; }
                    u32x4 w; w.x = pk_bf16(v0[0], v0[1]); w.y = pk_bf16(v0[2], v0[3]); w.z = pk_bf16(v1[0], v1[1]); w.w = pk_bf16(v1[2], v1[3]);
                    __builtin_nontemporal_store(w, (GAS u32x4*)(rowp + bj * 4 * 4096));
                }
            }
    }
};

template <class Epi, class Sched, bool ALIGN_EPI = false, bool SP2 = false>
__device__ __forceinline__ void gemm_phase(PG8_LAS unsigned char* lds, const Gemm g, const Sched& S, const Epi& E) {
    int tid = threadIdx.x; asm volatile("" : "+v"(tid));
    const int wid = __builtin_amdgcn_readfirstlane(tid >> 6), lane = tid & 63, wr = wid >> 2, wc = wid & 3, fr = lane & 15, fq = lane >> 4;
    const int K = g.K, nt = K / BK;
    unsigned voffA[2], voffB[2];
#pragma unroll
    for (int i = 0; i < 2; ++i) { int R, C; stage_rc(tid * 16 + i * 8192, R, C); const int Rb = Epi::PERM ? ((R & ~31) + perm32(R & 31)) : R;
        voffA[i] = g.tiledA ? (unsigned)((C >> 5) * 8192 + R * 64 + (C & 31) * 2) : (unsigned)(R * K + C) * 2u; voffB[i] = (unsigned)(Rb * K + C) * 2u; }
    const size_t kstep = (size_t)(BK * 2);
    const size_t kstepA = g.tiledA ? (size_t)16384 : kstep;
    const size_t hstep = (size_t)HALF * K * 2;
    const size_t tstep = 2 * hstep;
    const unsigned ldsw = (unsigned)wid * 1024u;
    const int aoff = lds_byte(wr * 64 + fr, fq * 8), boff = lds_byte(wc * 32 + fr, fq * 8);
#define PG8_SA(b, h) (((b) * 2 + (h)) * HTB)
#define PG8_SB(b, h) ((4 + (b) * 2 + (h)) * HTB)
#define PG8_STAGE(bufoff, gbase, voff) do { _Pragma("unroll") for (int _i = 0; _i < 2; ++_i) \
        __builtin_amdgcn_global_load_lds((const unsigned*)((const char*)(gbase) + (voff)[_i]), (PG8_LAS unsigned*)(lds + (bufoff) + ldsw + _i * 8192), 16, 0, 0); } while (0)
#define PG8_LDA(dst, b, h) do { _Pragma("unroll") for (int m = 0; m < 4; ++m) _Pragma("unroll") for (int k = 0; k < 2; ++k) dst[m][k] = *(const PG8_LAS bf16x8*)(lds + PG8_SA(b, h) + aoff + m * 2048 + k * 1024); } while (0)
#define PG8_LDB(dst, b, h) do { _Pragma("unroll") for (int n = 0; n < 2; ++n) _Pragma("unroll") for (int k = 0; k < 2; ++k) dst[n][k] = *(const PG8_LAS bf16x8*)(lds + PG8_SB(b, h) + boff + n * 2048 + k * 1024); } while (0)
#define PG8_MMA(ai, bj, At, Bt) do { __builtin_amdgcn_s_setprio(1); _Pragma("unroll") for (int m = 0; m < 4; ++m) _Pragma("unroll") for (int n = 0; n < 2; ++n) _Pragma("unroll") for (int k = 0; k < 2; ++k) \
        acc[ai][bj][m][n] = __builtin_amdgcn_mfma_f32_16x16x32_bf16(Bt[n][k], At[m][k], acc[ai][bj][m][n], 0, 0, 0); __builtin_amdgcn_s_setprio(0); } while (0)
#define PG8_WAIT_V(n) asm volatile("s_waitcnt vmcnt(" #n ")" ::: "memory")
#define PG8_WAIT_L(n) asm volatile("s_waitcnt lgkmcnt(" #n ")" ::: "memory")
#define PG8_BAR __builtin_amdgcn_s_barrier()
#define PG8_SCHED __builtin_amdgcn_sched_barrier(0)
    Unit cur, nxt; int ui = 0;
    if (!S.next(0, cur)) return;
    f32x4 acc[2][2][4][2];
#pragma unroll
    for (int a = 0; a < 2; ++a)
#pragma unroll
        for (int b = 0; b < 2; ++b)
#pragma unroll
            for (int m = 0; m < 4; ++m)
#pragma unroll
                for (int n = 0; n < 2; ++n) acc[a][b][m][n] = (f32x4){0.f, 0.f, 0.f, 0.f};
    bf16x8 At[4][2], B0[2][2], B1[2][2];
    const char* cA = (const char*)g.A + (size_t)cur.pm * tstep; const char* cB = (const char*)g.Bt + (size_t)cur.pn * tstep;
    S.a_ready(cur);
    if constexpr (SP2) {
        PG8_STAGE(PG8_SB(0, 0), cB, voffB); PG8_STAGE(PG8_SB(0, 1), cB + hstep, voffB); PG8_STAGE(PG8_SA(0, 0), cA, voffA); PG8_STAGE(PG8_SA(0, 1), cA + hstep, voffA);
        if (wr == 1) PG8_BAR;
        PG8_WAIT_V(2); PG8_BAR;
        PG8_STAGE(PG8_SB(1, 0), cB + kstep, voffB); PG8_STAGE(PG8_SA(1, 0), cA + kstepA, voffA); PG8_STAGE(PG8_SB(1, 1), cB + hstep + kstep, voffB);
        PG8_WAIT_V(6); PG8_BAR;
    } else {
        PG8_STAGE(PG8_SB(0, 0), cB, voffB); PG8_STAGE(PG8_SA(0, 0), cA, voffA); PG8_STAGE(PG8_SB(0, 1), cB + hstep, voffB); PG8_STAGE(PG8_SA(0, 1), cA + hstep, voffA);
        if (wr == 1) PG8_BAR;
        PG8_WAIT_V(4); PG8_BAR;
        PG8_STAGE(PG8_SB(1, 0), cB + kstep, voffB); PG8_STAGE(PG8_SA(1, 0), cA + kstepA, voffA); PG8_STAGE(PG8_SB(1, 1), cB + hstep + kstep, voffB);
        PG8_WAIT_V(6); PG8_BAR;
    }
    for (;;) {
        const bool has_next = S.next(ui + 1, nxt);
        const char* nA = has_next ? (const char*)g.A + (size_t)nxt.pm * tstep : cA; const char* nB = has_next ? (const char*)g.Bt + (size_t)nxt.pn * tstep : cB;
        for (int t = 0; t < nt; t += 2) {
            const bool last = (t == nt - 2);
            const char* a1 = cA + (size_t)(t + 1) * kstepA;
            const char* a2 = last ? nA : cA + (size_t)(t + 2) * kstepA; const char* b2 = last ? nB : cB + (size_t)(t + 2) * kstep;
            const char* a3 = a2 + kstepA; const char* b3 = b2 + kstep;
            if (last && has_next) S.a_ready(nxt);
            if constexpr (SP2) {
            PG8_LDB(B0, 0, 0); PG8_LDB(B1, 0, 1); PG8_SCHED; PG8_LDA(At, 0, 0); PG8_STAGE(PG8_SA(1, 1), a1 + hstep, voffA);
            PG8_WAIT_V(8); PG8_WAIT_L(0); PG8_BAR; PG8_MMA(0, 0, At, B0); PG8_MMA(0, 1, At, B1); PG8_BAR; PG8_SCHED;
            PG8_LDA(At, 0, 1); PG8_STAGE(PG8_SB(0, 0), b2, voffB); PG8_STAGE(PG8_SB(0, 1), b2 + hstep, voffB); PG8_STAGE(PG8_SA(0, 0), a2, voffA);
            PG8_WAIT_V(8); PG8_WAIT_L(0); PG8_BAR; PG8_MMA(1, 0, At, B0); PG8_MMA(1, 1, At, B1); PG8_BAR; PG8_SCHED;
            PG8_LDB(B0, 1, 0); PG8_LDB(B1, 1, 1); PG8_SCHED; PG8_LDA(At, 1, 0); PG8_STAGE(PG8_SA(0, 1), a2 + hstep, voffA);
            PG8_WAIT_V(8); PG8_WAIT_L(0); PG8_BAR; PG8_MMA(0, 0, At, B0); PG8_MMA(0, 1, At, B1); PG8_BAR; PG8_SCHED;
            PG8_LDA(At, 1, 1); PG8_STAGE(PG8_SB(1, 0), b3, voffB); PG8_STAGE(PG8_SB(1, 1), b3 + hstep, voffB); PG8_STAGE(PG8_SA(1, 0), a3, voffA);
            PG8_WAIT_V(8); PG8_WAIT_L(0); PG8_BAR; PG8_MMA(1, 0, At, B0); PG8_MMA(1, 1, At, B1); PG8_BAR; PG8_SCHED;
            } else {
            PG8_LDB(B0, 0, 0); PG8_SCHED; PG8_LDA(At, 0, 0); PG8_STAGE(PG8_SA(1, 1), a1 + hstep, voffA);
            PG8_WAIT_L(8); PG8_BAR; PG8_WAIT_L(0); PG8_MMA(0, 0, At, B0); PG8_BAR; PG8_SCHED;
            PG8_LDB(B1, 0, 1); PG8_STAGE(PG8_SB(0, 0), b2, voffB);
            PG8_BAR; PG8_WAIT_L(0); PG8_MMA(0, 1, At, B1); PG8_BAR;
            PG8_LDA(At, 0, 1); PG8_STAGE(PG8_SA(0, 0), a2, voffA);
            PG8_BAR; PG8_WAIT_L(0); PG8_MMA(1, 0, At, B0); PG8_BAR; PG8_SCHED;
            PG8_STAGE(PG8_SB(0, 1), b2 + hstep, voffB);
            PG8_WAIT_V(6); PG8_BAR; PG8_MMA(1, 1, At, B1); PG8_BAR;
            PG8_LDB(B0, 1, 0); PG8_SCHED; PG8_LDA(At, 1, 0); PG8_STAGE(PG8_SA(0, 1), a2 + hstep, voffA);
            PG8_WAIT_L(8); PG8_BAR; PG8_WAIT_L(0); PG8_MMA(0, 0, At, B0); PG8_BAR; PG8_SCHED;
            PG8_LDB(B1, 1, 1); PG8_STAGE(PG8_SB(1, 0), b3, voffB);
            PG8_BAR; PG8_WAIT_L(0); PG8_MMA(0, 1, At, B1); PG8_BAR;
            PG8_LDA(At, 1, 1); PG8_STAGE(PG8_SA(1, 0), a3, voffA);
            PG8_BAR; PG8_WAIT_L(0); PG8_MMA(1, 0, At, B0); PG8_BAR; PG8_SCHED;
            PG8_STAGE(PG8_SB(1, 1), b3 + hstep, voffB);
            PG8_WAIT_V(6); PG8_BAR; PG8_MMA(1, 1, At, B1); PG8_BAR;
            }
        }
        if constexpr (ALIGN_EPI) { if (wr == 0) PG8_BAR; }
        if constexpr (!Epi::AFTER_DRAIN) { E(acc, cur, wr, wc, fr, fq, ui); S.done(cur); }
        if (!has_next) break;
#pragma unroll
        for (int a = 0; a < 2; ++a)
#pragma unroll
            for (int b = 0; b < 2; ++b)
#pragma unroll
                for (int m = 0; m < 4; ++m)
#pragma unroll
                    for (int n = 0; n < 2; ++n) acc[a][b][m][n] = (f32x4){0.f, 0.f, 0.f, 0.f};
        cur = nxt; cA = nA; cB = nB; ++ui;
        if constexpr (ALIGN_EPI) { if (wr == 1) PG8_BAR; }
    }
    PG8_WAIT_V(0);
    if constexpr (!ALIGN_EPI) { if (wr == 0) PG8_BAR; }
    PG8_BAR;
    if constexpr (Epi::AFTER_DRAIN) { E.fused(acc, cur, wr, wc, fr, fq, lds, wid, lane); S.done(cur); }
#undef PG8_SA
#undef PG8_SB
#undef PG8_STAGE
#undef PG8_LDA
#undef PG8_LDB
#undef PG8_MMA
#undef PG8_WAIT_V
#undef PG8_WAIT_L
#undef PG8_BAR
#undef PG8_SCHED
}
}

#define DI __device__ __forceinline__
#define LAS __attribute__((address_space(3)))
typedef unsigned short bf16_t;
typedef short bf16x8 __attribute__((ext_vector_type(8)));
typedef short s16x4 __attribute__((ext_vector_type(4)));
typedef float f32x4 __attribute__((ext_vector_type(4)));
typedef float f32x2 __attribute__((ext_vector_type(2)));
typedef float f32x16 __attribute__((ext_vector_type(16)));
typedef unsigned u32x4 __attribute__((ext_vector_type(4)));
typedef unsigned u32x2 __attribute__((ext_vector_type(2)));
using pg8::pk_bf16;

constexpr int NWAVES = 8, NTHREADS = 512;
constexpr int DM = 1024, DFF = 2816, MH = 32768;
constexpr int ZW = 1792, QKVW = 3072;
constexpr float EPS = 1e-6f, LOG2E = 1.4426950408889634f, C2 = 0.125f * 1.4426950408889634f;
constexpr size_t MiB = 1u << 20;
constexpr int MT = 2 * MH;
constexpr size_t WS_ROPE_C = 1 * MiB, WS_ROPE_S = 1 * MiB + 131072, WS_SGUW = 1 * MiB + 524288;
constexpr size_t WS_WGU = 2 * MiB, WGU_STRIDE = 11 * MiB;
constexpr size_t WS_WD = 46 * MiB, WD_STRIDE = 5 * MiB + 524288;
constexpr size_t WS_WIN = 68 * MiB, WS_WOUT0 = 72 * MiB, WS_WQKV = 74 * MiB, WS_WOUT1 = 80 * MiB;
constexpr size_t WS_XN = 0;
constexpr size_t WS_BIG = 128 * MiB;
constexpr size_t WS_AB = WS_BIG + 224 * MiB;
constexpr size_t WS_KV = WS_BIG + 64 * MiB;
constexpr size_t WS_CTL = 480 * MiB;
constexpr size_t WS_SSP = 481 * MiB;
constexpr size_t WS_END = 485 * MiB;
constexpr int RL_OFF = 131072, RL_UNITS = 24;
constexpr int MISC_OFF = RL_OFF + RL_UNITS * 1024;
constexpr int LDS_BYTES = MISC_OFF + 64;
constexpr int NPHASES = 19;

DI float bf2f(unsigned short v) { return __builtin_bit_cast(float, (unsigned)v << 16); }
DI float bflo(unsigned v) { return __builtin_bit_cast(float, v << 16); }
DI float bfhi(unsigned v) { return __builtin_bit_cast(float, v & 0xffff0000u); }
DI float wave_sum(float v) {
#pragma unroll
    for (int o = 1; o < 64; o <<= 1) v += __shfl_xor(v, o);
    return v;
}
DI int clampi(int v, int lo, int hi) { return v < lo ? lo : (v > hi ? hi : v); }
DI int crow(int reg, int h) { return (reg & 3) + 8 * (reg >> 2) + 4 * h; }
DI size_t toff(size_t row, int col, int nslab) { return ((row >> 7) * nslab + (col >> 5)) * 4096 + (row & 127) * 32 + (col & 31); }
#define LDS_BARRIER() do { asm volatile("s_waitcnt lgkmcnt(0)" ::: "memory"); __builtin_amdgcn_s_barrier(); asm volatile("" ::: "memory"); } while (0)
#define MFMA32(a, b, c) __builtin_amdgcn_mfma_f32_32x32x16_bf16((a), (b), (c), 0, 0, 0)
DI s16x4 tr_read(LAS const char* p) { return __builtin_bit_cast(s16x4, __builtin_amdgcn_ds_read_tr16_b64_v4i16((LAS s16x4*)p)); }
DI bf16x8 pack8(const f32x16& x, int s) {
    u32x4 p; p.x = pk_bf16(x[8 * s], x[8 * s + 1]); p.y = pk_bf16(x[8 * s + 2], x[8 * s + 3]); p.z = pk_bf16(x[8 * s + 4], x[8 * s + 5]); p.w = pk_bf16(x[8 * s + 6], x[8 * s + 7]);
    return __builtin_bit_cast(bf16x8, p);
}

DI void p0_transpose_item(const float* W, int K, int N, bf16_t* WT, int mode, LAS float* scr, int item, int lane, const float* gain = nullptr) {
    const int nblk = N / 32, kb = item / nblk, nb = item % nblk, k0 = 64 * kb, n0 = 32 * nb;
    const int drow0 = mode == 0 ? n0 : (256 * (n0 >> 7) + (n0 & 127) + (mode == 2 ? 128 : 0));
#pragma unroll 8
    for (int i = 0; i < 32; ++i) { const int kk = 2 * i + (lane >> 5); scr[kk * 33 + (lane & 31)] = ((const GAS float*)W)[(size_t)(k0 + kk) * N + n0 + (lane & 31)]; }
    asm volatile("s_waitcnt lgkmcnt(0)" ::: "memory");
    const int c = lane & 7;
    f32x4 ga = {1.f, 1.f, 1.f, 1.f}, gb = ga;
    if (gain) { ga = *(const GAS f32x4*)(gain + k0 + 8 * c); gb = *(const GAS f32x4*)(gain + k0 + 8 * c + 4); }
#pragma unroll
    for (int j = 0; j < 4; ++j) { const int n = (lane >> 3) + 8 * j; const LAS float* s = scr + (8 * c) * 33 + n;
        u32x4 o; o.x = pk_bf16(s[0 * 33] * ga.x, s[1 * 33] * ga.y); o.y = pk_bf16(s[2 * 33] * ga.z, s[3 * 33] * ga.w); o.z = pk_bf16(s[4 * 33] * gb.x, s[5 * 33] * gb.y); o.w = pk_bf16(s[6 * 33] * gb.z, s[7 * 33] * gb.w);
        *(GAS u32x4*)(WT + (size_t)(drow0 + n) * K + k0 + 8 * c) = o; }
    asm volatile("s_waitcnt lgkmcnt(0)" ::: "memory");
}

struct Args { const float* in[31]; float* out; unsigned char* ws; int ph_lo, ph_hi; };

typedef const __attribute__((address_space(4))) char* kargp0_t;
#define A_IN(k) ((const float*)(*(const unsigned long long volatile __attribute__((address_space(4)))*)((kargp0_t)__builtin_amdgcn_kernarg_segment_ptr() + 8 * (k))))
DI void p0_phase(unsigned char* ws  , LAS unsigned char* lds, int gw, int NGW, int wave, int lane, int gtid, int gthreads) {
    LAS float* scr = (LAS float*)(lds + wave * 16384);
    constexpr int I_FF = 16 * 88;
    constexpr int I_IN = 16 * 56, I_O = 16 * 32, I_QKV = 16 * 96;
    constexpr int NITEMS = 12 * I_FF + I_IN + 2 * I_O + I_QKV;
    for (int it = gw; it < NITEMS; it += NGW) {
        int r = it; bool done = false;
#pragma unroll
        for (int f = 0; f < 4; ++f) {
            const int nf = (f == 0 ? 2 : (f == 1 ? 14 : (f == 2 ? 18 : 26)));
            bf16_t* wgu = (bf16_t*)(ws + WS_WGU + f * WGU_STRIDE); bf16_t* wd = (bf16_t*)(ws + WS_WD + f * WD_STRIDE);
            if (!done && r < I_FF) { p0_transpose_item(A_IN(nf + 1), DM, DFF, wgu, 1, scr, r, lane, A_IN(nf)); done = true; } r -= I_FF;
            if (!done && r >= 0 && r < I_FF) { p0_transpose_item(A_IN(nf + 2), DM, DFF, wgu, 2, scr, r, lane, A_IN(nf)); done = true; } r -= I_FF;
            if (!done && r >= 0 && r < I_FF) { p0_transpose_item(A_IN(nf + 3), DFF, DM, wd, 0, scr, r, lane); done = true; } r -= I_FF;
        }
        if (!done && r >= 0 && r < I_IN) { p0_transpose_item(A_IN(7), DM, ZW, (bf16_t*)(ws + WS_WIN), 0, scr, r, lane, A_IN(6)); done = true; } r -= I_IN;
        if (!done && r >= 0 && r < I_O) { p0_transpose_item(A_IN(13), DM, DM, (bf16_t*)(ws + WS_WOUT0), 0, scr, r, lane); done = true; } r -= I_O;
        if (!done && r >= 0 && r < I_QKV) { p0_transpose_item(A_IN(23), DM, QKVW, (bf16_t*)(ws + WS_WQKV), 0, scr, r, lane, A_IN(22)); done = true; } r -= I_QKV;
        if (!done && r >= 0 && r < I_O) { p0_transpose_item(A_IN(25), DM, DM, (bf16_t*)(ws + WS_WOUT1), 0, scr, r, lane); done = true; }
    }
    float* rc = (float*)(ws + WS_ROPE_C); float* rs = (float*)(ws + WS_ROPE_S);
    for (int i = gtid; i < 4096 * 8; i += gthreads) {
        const int pos = i >> 3, k = i & 7;
        const float inv = powf(500000.0f, -(float)(2 * k) / 16.0f);
        const float ang = (float)pos * inv;
        ((GAS float*)rc)[i] = cosf(ang); ((GAS float*)rs)[i] = sinf(ang);
    }
    bf16_t* sw = (bf16_t*)(ws + WS_SGUW);
    for (int i = gtid; i < 4 * 128 * 128 / 2; i += gthreads) { const f32x2 v = ((const GAS f32x2*)A_IN(10))[i]; ((GAS unsigned*)sw)[i] = pk_bf16(v.x, v.y); }
}

DI void convert_phase(const float* xin0, const float* xin1, bf16_t* XB, float* SSP, int gw, int NGW, int lane) {
    for (int m = gw; m < MT; m += NGW) {
        const GAS f32x4* xr = (const GAS f32x4*)(m < MH ? xin0 + (size_t)m * DM : xin1 + (size_t)(m - MH) * DM) + lane;
        f32x4 v[4]; float s = 0.f;
#pragma unroll
        for (int j = 0; j < 4; ++j) { v[j] = xr[64 * j]; s += (v[j].x * v[j].x + v[j].y * v[j].y) + (v[j].z * v[j].z + v[j].w * v[j].w); }
        s = wave_sum(s);
        bf16_t* ob = XB + (size_t)(m >> 7) * 32 * 4096 + (m & 127) * 32;
#pragma unroll
        for (int j = 0; j < 4; ++j) { const int cidx = 4 * lane + 256 * j; u32x2 w; w.x = pk_bf16(v[j].x, v[j].y); w.y = pk_bf16(v[j].z, v[j].w); *(GAS u32x2*)(ob + (size_t)(cidx >> 5) * 4096 + (cidx & 31)) = w; }
        if (lane < 16) ((GAS float*)SSP)[(size_t)m * 16 + lane] = lane == 0 ? s : 0.f;
    }
}
DI void final_norm_phase(const bf16_t* XB, float* out, const float* SSP, const float* gain, int gw, int NGW, int lane) {
    f32x4 g[4];
#pragma unroll
    for (int j = 0; j < 4; ++j) g[j] = ((const GAS f32x4*)gain)[lane + 64 * j];
    for (int m = gw; m < MT; m += NGW) {
        const bf16_t* xb = XB + (size_t)(m >> 7) * 32 * 4096 + (m & 127) * 32;
        u32x2 v[4];
#pragma unroll
        for (int j = 0; j < 4; ++j) { const int cidx = 4 * lane + 256 * j; v[j] = *(const GAS u32x2*)(xb + (size_t)(cidx >> 5) * 4096 + (cidx & 31)); }
        float s = ((const GAS float*)SSP)[(size_t)m * 16 + (lane & 15)];
        s += __shfl_xor(s, 1); s += __shfl_xor(s, 2); s += __shfl_xor(s, 4); s += __shfl_xor(s, 8);
        const float r = 1.0f / sqrtf(s * (1.f / DM) + EPS);
        GAS f32x4* o = (GAS f32x4*)(out + (size_t)m * DM) + lane;
#pragma unroll
        for (int j = 0; j < 4; ++j) { const f32x4 x = {bflo(v[j].x), bfhi(v[j].x), bflo(v[j].y), bfhi(v[j].y)}; o[64 * j] = x * r * g[j]; }
    }
}
template <class Sched> DI void precompute_rl(LAS unsigned char* lds, const Sched& S, const float* SSP, int tid) {
    LAS float* rl = (LAS float*)(lds + RL_OFF);
#pragma unroll 1
    for (int i0 = 0; i0 < RL_UNITS; i0 += 8) {
        f32x4 a[8], b[8]; bool ok[8];
#pragma unroll
        for (int j = 0; j < 8; ++j) {
            pg8::Unit u; ok[j] = S.next(i0 + j, u);
            if (ok[j]) { const GAS f32x4* p = (const GAS f32x4*)(SSP + (size_t)(u.pm * 256 + (tid >> 1)) * 16 + 8 * (tid & 1)); a[j] = p[0]; b[j] = p[1]; }
        }
        if (!ok[0]) break;
#pragma unroll
        for (int j = 0; j < 8; ++j) {
            if (ok[j]) {
                float s = (a[j].x + a[j].y) + (a[j].z + a[j].w) + (b[j].x + b[j].y) + (b[j].z + b[j].w);
                s += __shfl_xor(s, 1);
                if (!(tid & 1)) rl[(i0 + j) * 256 + (tid >> 1)] = 1.0f / sqrtf(s * (1.f / DM) + EPS);
            }
        }
    }
    __syncthreads();
}

template <class SF>
DI void attn_tile(f32x16& o0, f32x16& o1, float& m, float& l, const bf16x8 (&q)[4], LAS const char* Kt, LAS const char* Vt, int lane, SF sfun) {
    const int r = lane & 31, h = lane >> 5;
    f32x16 st;
#pragma unroll
    for (int i = 0; i < 16; ++i) st[i] = 0.f;
    {
        LAS const char* kp = Kt + r * 128; const int sw = r & 7;
#pragma unroll
        for (int s = 0; s < 4; ++s) { const bf16x8 kf = *(LAS const bf16x8*)(kp + (((2 * s + h) ^ sw) << 4)); st = MFMA32(kf, q[s], st); }
    }
    float mx = -1e30f;
#pragma unroll
    for (int i = 0; i < 16; ++i) { st[i] = sfun(i, st[i]); mx = fmaxf(mx, st[i]); }
    mx = fmaxf(mx, __shfl_xor(mx, 32));
    if (__any(mx > m + 8.0f)) {
        const float mn = fmaxf(m, mx), alpha = __builtin_amdgcn_exp2f(m - mn); m = mn;
        l *= alpha;
#pragma unroll
        for (int i = 0; i < 16; ++i) { o0[i] *= alpha; o1[i] *= alpha; }
    }
    float ps = 0.f;
#pragma unroll
    for (int i = 0; i < 16; ++i) { st[i] = __builtin_amdgcn_exp2f(st[i] - m); ps += st[i]; }
    l += ps;
    const int blk = (lane >> 4) & 1, q4 = (lane & 15) >> 2, p = lane & 3, rsw = 4 * h + q4;
#pragma unroll
    for (int s = 0; s < 2; ++s) {
        const bf16x8 pb = pack8(st, s);
        LAS const char* vrow = Vt + (16 * s + 4 * h + q4) * 128 + 8 * (p & 1);
#pragma unroll
        for (int dt = 0; dt < 2; ++dt) {
            const int ch = ((4 * dt + 2 * blk + (p >> 1)) ^ rsw) << 4;
            const s16x4 lo = tr_read(vrow + ch), hi = tr_read(vrow + 8 * 128 + ch);
            const bf16x8 vf = __builtin_shufflevector(lo, hi, 0, 1, 2, 3, 4, 5, 6, 7);
            if (dt == 0) o0 = MFMA32(vf, pb, o0); else o1 = MFMA32(vf, pb, o1);
        }
    }
}
template <class SF0, class SF1>
DI void attn_tile2(f32x16& o0, f32x16& o1, float& m, float& l, const bf16x8 (&q)[4], LAS const char* K0, LAS const char* V0, LAS const char* K1, LAS const char* V1, int lane, SF0 f0, SF1 f1) {
    const int r = lane & 31, h = lane >> 5;
    f32x16 sa, sb;
#pragma unroll
    for (int i = 0; i < 16; ++i) { sa[i] = 0.f; sb[i] = 0.f; }
    {
        const int sw = r & 7; LAS const char* kp0 = K0 + r * 128; LAS const char* kp1 = K1 + r * 128;
#pragma unroll
        for (int s = 0; s < 4; ++s) {
            const int co = (((2 * s + h) ^ sw) << 4);
            const bf16x8 ka = *(LAS const bf16x8*)(kp0 + co), kb = *(LAS const bf16x8*)(kp1 + co);
            sa = MFMA32(ka, q[s], sa); sb = MFMA32(kb, q[s], sb);
        }
    }
    float mx = -1e30f;
#pragma unroll
    for (int i = 0; i < 16; ++i) { sa[i] = f0(i, sa[i]); sb[i] = f1(i, sb[i]); mx = fmaxf(fmaxf(mx, sa[i]), sb[i]); }
    mx = fmaxf(mx, __shfl_xor(mx, 32));
    if (__any(mx > m + 8.0f)) {
        const float mn = fmaxf(m, mx), alpha = __builtin_amdgcn_exp2f(m - mn); m = mn;
        l *= alpha;
#pragma unroll
        for (int i = 0; i < 16; ++i) { o0[i] *= alpha; o1[i] *= alpha; }
    }
    float ps = 0.f;
#pragma unroll
    for (int i = 0; i < 16; ++i) { sa[i] = __builtin_amdgcn_exp2f(sa[i] - m); sb[i] = __builtin_amdgcn_exp2f(sb[i] - m); ps += sa[i] + sb[i]; }
    l += ps;
    const int blk = (lane >> 4) & 1, q4 = (lane & 15) >> 2, p = lane & 3, rsw = 4 * h + q4;
#pragma unroll
    for (int s = 0; s < 2; ++s) {
        const bf16x8 fa = pack8(sa, s), fb = pack8(sb, s);
        const int ro = (16 * s + 4 * h + q4) * 128 + 8 * (p & 1);
#pragma unroll
        for (int dt = 0; dt < 2; ++dt) {
            const int ch = ((4 * dt + 2 * blk + (p >> 1)) ^ rsw) << 4;
            const s16x4 alo = tr_read(V0 + ro + ch), ahi = tr_read(V0 + ro + 8 * 128 + ch), blo = tr_read(V1 + ro + ch), bhi = tr_read(V1 + ro + 8 * 128 + ch);
            const bf16x8 vfa = __builtin_shufflevector(alo, ahi, 0, 1, 2, 3, 4, 5, 6, 7), vfb = __builtin_shufflevector(blo, bhi, 0, 1, 2, 3, 4, 5, 6, 7);
            if (dt == 0) { o0 = MFMA32(vfa, fa, o0); o0 = MFMA32(vfb, fb, o0); } else { o1 = MFMA32(vfa, fa, o1); o1 = MFMA32(vfb, fb, o1); }
        }
    }
}
DI void attn_store(const f32x16& o0, const f32x16& o1, float inv_l, bf16_t* orow  , int h) {
#pragma unroll
    for (int i4 = 0; i4 < 4; ++i4) {
        u32x2 w0, w1;
        w0.x = pk_bf16(o0[4 * i4] * inv_l, o0[4 * i4 + 1] * inv_l); w0.y = pk_bf16(o0[4 * i4 + 2] * inv_l, o0[4 * i4 + 3] * inv_l);
        w1.x = pk_bf16(o1[4 * i4] * inv_l, o1[4 * i4 + 1] * inv_l); w1.y = pk_bf16(o1[4 * i4 + 2] * inv_l, o1[4 * i4 + 3] * inv_l);
        *(GAS u32x2*)(orow + 8 * i4 + 4 * h) = w0; *(GAS u32x2*)(orow + 4096 + 8 * i4 + 4 * h) = w1;
    }
}
DI void rope16(u32x4& a, u32x4& b, const float* rc, const float* rs, int pos) {
    const f32x4 c0 = *(const GAS f32x4*)(rc + pos * 8), c1 = *(const GAS f32x4*)(rc + pos * 8 + 4), s0 = *(const GAS f32x4*)(rs + pos * 8), s1 = *(const GAS f32x4*)(rs + pos * 8 + 4);
    const float cs[8] = {c0.x, c0.y, c0.z, c0.w, c1.x, c1.y, c1.z, c1.w}, sn[8] = {s0.x, s0.y, s0.z, s0.w, s1.x, s1.y, s1.z, s1.w};
    const unsigned av[4] = {a.x, a.y, a.z, a.w}, bv[4] = {b.x, b.y, b.z, b.w};
    unsigned ao[4], bo[4];
#pragma unroll
    for (int j = 0; j < 4; ++j) {
        const float x1l = bflo(av[j]), x1h = bfhi(av[j]), x2l = bflo(bv[j]), x2h = bfhi(bv[j]);
        ao[j] = pk_bf16(x1l * cs[2 * j] - x2l * sn[2 * j], x1h * cs[2 * j + 1] - x2h * sn[2 * j + 1]);
        bo[j] = pk_bf16(x2l * cs[2 * j] + x1l * sn[2 * j], x2h * cs[2 * j + 1] + x1h * sn[2 * j + 1]);
    }
    a = (u32x4){ao[0], ao[1], ao[2], ao[3]}; b = (u32x4){bo[0], bo[1], bo[2], bo[3]};
}

DI void swa_unit(LAS unsigned char* ldsu, const bf16_t* Z, bf16_t* AB, const float* rc, const float* rs, const float* sink, int rowbase, int b, int n, int g, int L, int tid) {
    LAS char* lds = (LAS char*)ldsu;
    const int lane = tid & 63, w = tid >> 6, r = lane & 31, h = lane >> 5;
    LAS char* Ks = lds; LAS char* Vs = lds + 49152;
    for (int it = tid; it < 1536; it += NTHREADS) {
        const int kr = it >> 2, seg = it & 3, pos = 128 * (n - 1) + kr;
        if (pos < 0 || pos >= L) continue;
        const size_t zr = (size_t)(rowbase + b * L + pos);
        const bf16_t* kp = Z + toff(zr, 1536 + 64 * g + 16 * seg, ZW / 32); const bf16_t* vp = Z + toff(zr, 1664 + 64 * g + 16 * seg, ZW / 32);
        u32x4 k0 = *(const GAS u32x4*)kp, k1 = *(const GAS u32x4*)(kp + 8);
        const u32x4 v0 = *(const GAS u32x4*)vp, v1 = *(const GAS u32x4*)(vp + 8);
        if (seg == 0) rope16(k0, k1, rc, rs, pos);
        const int sw = kr & 7, c0 = ((2 * seg) ^ sw) << 4, c1 = ((2 * seg + 1) ^ sw) << 4;
        *(LAS u32x4*)(Ks + kr * 128 + c0) = k0; *(LAS u32x4*)(Ks + kr * 128 + c1) = k1;
        *(LAS u32x4*)(Vs + kr * 128 + c0) = v0; *(LAS u32x4*)(Vs + kr * 128 + c1) = v1;
    }
    __syncthreads();
#pragma unroll 1
    for (int qq = 0; qq < 2; ++qq) {
        const int qi = 2 * w + qq, r4 = qi >> 2, qt = qi & 3, head = 4 * g + r4;
        const int qpos = 128 * n + 32 * qt + r;
        const size_t qr_ = (size_t)(rowbase + b * L + qpos);
        bf16x8 q[4];
#pragma unroll
        for (int s = 0; s < 4; ++s) q[s] = *(const GAS bf16x8*)(Z + toff(qr_, 1024 + 64 * head + 16 * s + 8 * h, ZW / 32));
        {
            const u32x4 mine = __builtin_bit_cast(u32x4, q[0]);
            u32x4 oth; oth.x = __shfl_xor(mine.x, 32); oth.y = __shfl_xor(mine.y, 32); oth.z = __shfl_xor(mine.z, 32); oth.w = __shfl_xor(mine.w, 32);
            const f32x4 c0 = *(const GAS f32x4*)(rc + qpos * 8), c1 = *(const GAS f32x4*)(rc + qpos * 8 + 4), s0 = *(const GAS f32x4*)(rs + qpos * 8), s1 = *(const GAS f32x4*)(rs + qpos * 8 + 4);
            const float cs[8] = {c0.x, c0.y, c0.z, c0.w, c1.x, c1.y, c1.z, c1.w}, sn[8] = {s0.x, s0.y, s0.z, s0.w, s1.x, s1.y, s1.z, s1.w};
            const unsigned mv[4] = {mine.x, mine.y, mine.z, mine.w}, ov[4] = {oth.x, oth.y, oth.z, oth.w};
            const float sg = h ? 1.f : -1.f; unsigned res[4];
#pragma unroll
            for (int j = 0; j < 4; ++j) res[j] = pk_bf16(bflo(mv[j]) * cs[2 * j] + sg * bflo(ov[j]) * sn[2 * j], bfhi(mv[j]) * cs[2 * j + 1] + sg * bfhi(ov[j]) * sn[2 * j + 1]);
            q[0] = __builtin_bit_cast(bf16x8, (u32x4){res[0], res[1], res[2], res[3]});
        }
        f32x16 o0, o1;
#pragma unroll
        for (int i = 0; i < 16; ++i) { o0[i] = 0.f; o1[i] = 0.f; }
        float m = -1e30f, l = 0.f;
        {
            const int nb = L / 128;
            const int dk_lo = n == 0 ? (4 - qt > 0 ? 4 - qt : 0) : 0, dk_hi = n == nb - 1 ? (7 - qt < 8 ? 7 - qt : 8) : 8;
            if (dk_lo == 0) attn_tile(o0, o1, m, l, q, Ks + qt * 4096, Vs + qt * 4096, lane, [&](int i, float s) { return crow(i, h) >= r ? s * C2 : -1e30f; });
            int d = dk_lo > 1 ? dk_lo : 1; const int de = dk_hi < 7 ? dk_hi : 7;
#pragma unroll 1
            for (; d + 1 <= de; d += 2) { const int kt = qt + d;
                attn_tile2(o0, o1, m, l, q, Ks + kt * 4096, Vs + kt * 4096, Ks + (kt + 1) * 4096, Vs + (kt + 1) * 4096, lane, [&](int i, float s) { return s * C2; }, [&](int i, float s) { return s * C2; }); }
            if (d <= de) attn_tile(o0, o1, m, l, q, Ks + (qt + d) * 4096, Vs + (qt + d) * 4096, lane, [&](int i, float s) { return s * C2; });
            if (dk_hi == 8) attn_tile(o0, o1, m, l, q, Ks + (qt + 8) * 4096, Vs + (qt + 8) * 4096, lane, [&](int i, float s) { return crow(i, h) <= r ? s * C2 : -1e30f; });
        }
        const float lt = l + __shfl_xor(l, 32) + __builtin_amdgcn_exp2f(((const GAS float*)sink)[head] * LOG2E - m);
        attn_store(o0, o1, 1.0f / lt, AB + toff(qr_, 512 + 64 * head, DM / 32), h);
    }
    __syncthreads();
}

constexpr int SGU_PITCH = 1040;
DI void sgu_unit(LAS unsigned char* ldsu, const bf16_t* Z, bf16_t* AB, const bf16_t* SW, const float* sgu_b, const float* ln_g, const float* ln_b, int t0, int tid) {
    LAS char* lds = (LAS char*)ldsu;
    const int lane = tid & 63, w = tid >> 6, r = lane & 31, h = lane >> 5;
    const int g = w >> 1, chf = w & 1;
    const bf16_t* wg = SW + (size_t)g * 128 * 128 + (size_t)r * 128 + 8 * h;
    {
        const f32x4 g0 = *(const GAS f32x4*)(ln_g + 8 * lane), g1 = *(const GAS f32x4*)(ln_g + 8 * lane + 4), b0 = *(const GAS f32x4*)(ln_b + 8 * lane), b1 = *(const GAS f32x4*)(ln_b + 8 * lane + 4);
#pragma unroll 1
        for (int tb = 0; tb < 16; tb += 8) {
        u32x4 zv[8];
#pragma unroll
        for (int t = 0; t < 8; ++t) zv[t] = *(const GAS u32x4*)(Z + toff((size_t)(t0 + 16 * w + tb + t), 512 + 8 * lane, ZW / 32));
#pragma unroll
        for (int t = 0; t < 8; ++t) {
            const int tok = 16 * w + tb + t;
            f32x4 x0 = {bflo(zv[t].x), bfhi(zv[t].x), bflo(zv[t].y), bfhi(zv[t].y)}, x1 = {bflo(zv[t].z), bfhi(zv[t].z), bflo(zv[t].w), bfhi(zv[t].w)};
            const float mu = wave_sum((x0.x + x0.y) + (x0.z + x0.w) + (x1.x + x1.y) + (x1.z + x1.w)) * (1.f / 512.f);
            x0 = x0 - mu; x1 = x1 - mu;
            const float var = wave_sum((x0.x * x0.x + x0.y * x0.y) + (x0.z * x0.z + x0.w * x0.w) + (x1.x * x1.x + x1.y * x1.y) + (x1.z * x1.z + x1.w * x1.w)) * (1.f / 512.f);
            const float rstd = 1.0f / sqrtf(var + EPS);
            const f32x4 y0 = x0 * rstd * g0 + b0, y1 = x1 * rstd * g1 + b1;
            u32x4 o; o.x = pk_bf16(y0.x, y0.y); o.y = pk_bf16(y0.z, y0.w); o.z = pk_bf16(y1.x, y1.y); o.w = pk_bf16(y1.z, y1.w);
            *(LAS u32x4*)(lds + tok * SGU_PITCH + 16 * lane) = o;
        }
        }
    }
    __syncthreads();
    const int blk = (lane >> 4) & 1, q4 = (lane & 15) >> 2, p = lane & 3;
    LAS const char* abase = lds + (8 * h + q4) * SGU_PITCH + (128 * g + 64 * chf + 16 * blk) * 2 + 8 * p;
#pragma unroll
    for (int it = 0; it < 4; ++it) {
        const int tok = 32 * it + r;
        const bf16_t* urow = Z + toff((size_t)(t0 + tok), 128 * g + 64 * chf, ZW / 32) + 4 * h;
        u32x2 uu[2][4];
#pragma unroll
        for (int ct = 0; ct < 2; ++ct)
#pragma unroll
            for (int i4 = 0; i4 < 4; ++i4) uu[ct][i4] = *(const GAS u32x2*)(urow + 4096 * ct + 8 * i4);
        const float bias = ((const GAS float*)sgu_b)[g * 128 + tok];
        bf16x8 bcur[8];
#pragma unroll
        for (int s = 0; s < 8; ++s) bcur[s] = *(const GAS bf16x8*)(wg + (size_t)(32 * it) * 128 + 16 * s);
        f32x16 acc[2];
#pragma unroll
        for (int ct = 0; ct < 2; ++ct)
#pragma unroll
            for (int i = 0; i < 16; ++i) acc[ct][i] = 0.f;
#pragma unroll
        for (int s = 0; s < 8; ++s) {
#pragma unroll
            for (int ct = 0; ct < 2; ++ct) {
                LAS const char* base = abase + 16 * s * SGU_PITCH + 64 * ct;
                const s16x4 lo = tr_read(base), hi = tr_read(base + 4 * SGU_PITCH);
                const bf16x8 af = __builtin_shufflevector(lo, hi, 0, 1, 2, 3, 4, 5, 6, 7);
                acc[ct] = MFMA32(af, bcur[s], acc[ct]);
            }
        }
        bf16_t* orow = AB + toff((size_t)(t0 + tok), 128 * g + 64 * chf, DM / 32) + 4 * h;
#pragma unroll
        for (int ct = 0; ct < 2; ++ct)
#pragma unroll
            for (int i4 = 0; i4 < 4; ++i4) {
                const u32x2 u2 = uu[ct][i4];
                u32x2 o; o.x = pk_bf16(bflo(u2.x) * (acc[ct][4 * i4] + bias), bfhi(u2.x) * (acc[ct][4 * i4 + 1] + bias));
                o.y = pk_bf16(bflo(u2.y) * (acc[ct][4 * i4 + 2] + bias), bfhi(u2.y) * (acc[ct][4 * i4 + 3] + bias));
                *(GAS u32x2*)(orow + 4096 * ct + 8 * i4) = o;
            }
    }
    __syncthreads();
}

DI void na_unit(LAS unsigned char* ldsu, bf16_t* QO  , const bf16_t* KV  , const float* rpb, int b, int hh, int rg, int L, int tid) {
    LAS char* lds = (LAS char*)ldsu;
    const int lane = tid & 63, w = tid >> 6, r = lane & 31, h = lane >> 5;
    const int rows = L / 64, r0 = 4 * rg;
    const int lo = clampi(r0 - 4, 0, rows - 8), hiE = clampi(r0 - 1, 0, rows - 8) + 8;
    LAS float* rpbL = (LAS float*)(lds + 65536);
    for (int i = tid; i < 15 * 128; i += NTHREADS) { const int dr = i >> 7, dc = (i & 127) - 48; rpbL[i] = (dc >= 0 && dc < 31) ? ((const GAS float*)rpb)[hh * 465 + dr * 31 + dc] * LOG2E : 0.f; }
    const int cg = w & 3, qrA = r0 + 2 * (w >> 2);
    const int qr = qrA + (r >> 4), c = 16 * cg + (r & 15), rsb = clampi(qr - 4, 0, rows - 8), cs = clampi(c - 8, 0, 48);
    const int cs0 = clampi(16 * cg - 8, 0, 32), rsA = clampi(qrA - 4, 0, rows - 8), rsB = clampi(qrA - 3, 0, rows - 8);
    const size_t tokq = (size_t)b * L + 64 * qr + c;
    bf16x8 q[4];
#pragma unroll
    for (int s = 0; s < 4; ++s) q[s] = *(const GAS bf16x8*)(QO + toff(tokq, 64 * hh + 16 * s + 8 * h, DM / 32));
    f32x16 o0, o1;
#pragma unroll
    for (int i = 0; i < 16; ++i) { o0[i] = 0.f; o1[i] = 0.f; }
    float m = -1e30f, l = 0.f;
    float madd[16];
#pragma unroll
    for (int i = 0; i < 16; ++i) { const int kcol = cs0 + crow(i, h); madd[i] = (kcol >= cs && kcol < cs + 16) ? 0.f : -1e30f; }
    const int kc = tid >> 3, chunk = tid & 7;
    constexpr int KVW = 2048;
    (void)KVW;
#define NA_KOFF(row_) toff((size_t)b * L + 64 * (row_) + kc, 64 * hh + 8 * chunk, 64)
    const int stoff = kc * 128 + ((chunk ^ (kc & 7)) << 4);
    u32x4 kreg[4], vreg[4];
#pragma unroll
    for (int j = 0; j < 4; ++j) if (lo + j < hiE) { const bf16_t* kp_ = KV + NA_KOFF(lo + j); kreg[j] = *(const GAS u32x4*)kp_; vreg[j] = *(const GAS u32x4*)(kp_ + 131072); }
    int cur = 0;
#pragma unroll 1
    for (int base = lo; base < hiE; base += 4) {
#pragma unroll
        for (int j = 0; j < 4; j += 2) {
            const int kr = base + j;
            if (kr < hiE) {
                LAS char* Kb = lds + cur * 32768; LAS char* Vb = Kb + 8192;
                *(LAS u32x4*)(Kb + stoff) = kreg[j]; *(LAS u32x4*)(Vb + stoff) = vreg[j];
                if (kr + 1 < hiE) { *(LAS u32x4*)(Kb + 16384 + stoff) = kreg[j + 1]; *(LAS u32x4*)(Vb + 16384 + stoff) = vreg[j + 1]; }
                LDS_BARRIER();
                if (kr + 4 < hiE) { const bf16_t* kp_ = KV + NA_KOFF(kr + 4); kreg[j] = *(const GAS u32x4*)kp_; vreg[j] = *(const GAS u32x4*)(kp_ + 131072); }
                if (kr + 5 < hiE) { const bf16_t* kp_ = KV + NA_KOFF(kr + 5); kreg[j + 1] = *(const GAS u32x4*)kp_; vreg[j + 1] = *(const GAS u32x4*)(kp_ + 131072); }
                if (kr + 1 >= rsA && kr < rsB + 8) {
                    LAS const float* brow0 = rpbL + clampi(kr - qr + 7, 0, 14) * 128 + 63 - c + cs0 + 4 * h;
                    LAS const float* brow1 = rpbL + clampi(kr + 1 - qr + 7, 0, 14) * 128 + 63 - c + cs0 + 4 * h;
                    const float radd0 = (kr >= rsb && kr < rsb + 8) ? 0.f : -1e30f, radd1 = (kr + 1 >= rsb && kr + 1 < rsb + 8) ? 0.f : -1e30f;
                    attn_tile2(o0, o1, m, l, q, Kb + cs0 * 128, Vb + cs0 * 128, Kb + 16384 + cs0 * 128, Vb + 16384 + cs0 * 128, lane,
                        [&](int i, float s) { return fmaf(s, C2, brow0[(i & 3) + 8 * (i >> 2)]) + (madd[i] + radd0); },
                        [&](int i, float s) { return fmaf(s, C2, brow1[(i & 3) + 8 * (i >> 2)]) + (madd[i] + radd1); });
                }
                cur ^= 1;
            }
        }
    }
    const float lt = l + __shfl_xor(l, 32);
    attn_store(o0, o1, 1.0f / lt, QO + toff(tokq, 64 * hh, DM / 32), h);
    __syncthreads();
}

#define XB_TMO      128
#define XB_XCNT(j)  (256  + 64 * (j))
#define XB_XSUB(j)  (1280 + 64 * (j))
#define XB_XGEN(j)  (2304 + 64 * (j))
#define XB_TOP      3328
#define XB_TOPGEN   3392
#define XCD_BAR_WORDS 3456
#define XB_SPIN_CAP (1u << 18)

__device__ __forceinline__ unsigned xb_ld(unsigned* p)              { return __hip_atomic_load(p, __ATOMIC_RELAXED, __HIP_MEMORY_SCOPE_AGENT); }
__device__ __forceinline__ unsigned xb_add(unsigned* p, unsigned v) { return __hip_atomic_fetch_add(p, v, __ATOMIC_RELAXED, __HIP_MEMORY_SCOPE_AGENT); }
__device__ __forceinline__ unsigned xb_xcc_id() { return (unsigned)__builtin_amdgcn_s_getreg((3 << 11) | 20) & 0xFu; }
#define XB_SPIN(cond, bar) do { unsigned _sp = 0; while (cond) { __builtin_amdgcn_s_sleep(1); \
    if ((++_sp & 255u) == 0u) { if (xb_ld(&(bar)[XB_TMO])) break; if (_sp > XB_SPIN_CAP) { atomicAdd(&(bar)[XB_TMO], 1u); break; } } } } while (0)

struct XcdBarrier {
    unsigned* bar; unsigned x;
    volatile LAS unsigned* st;
};

__device__ __forceinline__ XcdBarrier xcd_barrier_post(unsigned* bar, volatile LAS unsigned* st) {
    XcdBarrier b; b.bar = bar; b.x = xb_xcc_id(); b.st = st;
    if (threadIdx.x == 0) (void)xb_add(&bar[XB_XCNT(b.x)], 1u);
    return b;
}
__device__ __forceinline__ void xcd_barrier_complete(unsigned* bar, unsigned x, unsigned& nloc, unsigned& nx) {
    const unsigned G = gridDim.x * gridDim.y * gridDim.z;
    unsigned sum, cnt, mine, sp = 0u;
    for (;;) {
        sum = 0u; cnt = 0u; mine = 0u;
#pragma unroll
        for (unsigned j = 0; j < 16; ++j) { const unsigned c = xb_ld(&bar[XB_XCNT(j)]); sum += c; cnt += (c > 0u) ? 1u : 0u; mine = (j == x) ? c : mine; }
        if (sum == G) break;
        __builtin_amdgcn_s_sleep(1);
        if ((++sp & 255u) == 0u) { if (xb_ld(&bar[XB_TMO])) break; if (sp > XB_SPIN_CAP) { atomicAdd(&bar[XB_TMO], 1u); break; } }
    }
    nloc = mine > 0u ? mine : 1u; nx = cnt > 0u ? cnt : 1u;
}

__device__ __forceinline__ void xcd_barrier(const XcdBarrier& b) {
    asm volatile("s_waitcnt vmcnt(0)" ::: "memory");
    __syncthreads();
    if (threadIdx.x == 0) {
        unsigned* bar = b.bar;
        __builtin_amdgcn_s_waitcnt(0);
        unsigned nloc = b.st[0], nx = b.st[1];
        if (nloc == 0u) { xcd_barrier_complete(bar, b.x, nloc, nx); b.st[0] = nloc; b.st[1] = nx; }
        const unsigned old = xb_add(&bar[XB_XSUB(b.x)], 1u);
        const unsigned gen = old / nloc;
        if (old + 1u == (gen + 1u) * nloc) {
            __builtin_amdgcn_fence(__ATOMIC_RELEASE, "agent");
            asm volatile("s_waitcnt vmcnt(0)" ::: "memory");
            const unsigned og = xb_add(&bar[XB_TOP], 1u);
            const unsigned tg = og / nx;
            if (og + 1u == (tg + 1u) * nx) xb_add(&bar[XB_TOPGEN], 1u);
            else XB_SPIN(xb_ld(&bar[XB_TOPGEN]) == tg, bar);
            __builtin_amdgcn_fence(__ATOMIC_ACQUIRE, "agent");
            xb_add(&bar[XB_XGEN(b.x)], 1u);
            asm volatile("s_waitcnt vmcnt(0)" ::: "memory");
        } else {
            XB_SPIN(xb_ld(&bar[XB_XGEN(b.x)]) == gen, bar);
            __builtin_amdgcn_fence(__ATOMIC_ACQUIRE, "agent");
            asm volatile("s_waitcnt vmcnt(0)" ::: "memory");
        }
    }
    __syncthreads();
}

constexpr size_t WS_BAR = WS_CTL + 16384;

typedef const __attribute__((address_space(4))) char* kargp_t;
#define KARG_PTR(T, k) ((T)(*(const unsigned long long volatile __attribute__((address_space(4)))*)((kargp_t)__builtin_amdgcn_kernarg_segment_ptr() + 8 * (k))))
#define KARG_IN(k) KARG_PTR(const float*, (k))
#define KARG_OUT() KARG_PTR(float*, 31)
#define KARG_WS() KARG_PTR(unsigned char*, 32)

__global__ void __launch_bounds__(NTHREADS, 2) fwd_megakernel(Args args) {
    extern __shared__ __attribute__((aligned(16))) unsigned char lds_raw[];
    LAS unsigned char* lds = (LAS unsigned char*)lds_raw;
    cg::grid_group grid = cg::this_grid();
    const int ph_lo = args.ph_lo, ph_hi = args.ph_hi;
    if (threadIdx.x < 16) ((LAS unsigned*)(lds + MISC_OFF))[threadIdx.x] = 0u;
    __syncthreads();
    XcdBarrier xbar; xbar.bar = (unsigned*)(KARG_WS() + WS_BAR); xbar.x = xb_xcc_id(); xbar.st = (volatile LAS unsigned*)(lds + MISC_OFF);
    if (threadIdx.x == 0) { const unsigned rank = xb_add(&xbar.bar[XB_XCNT(xbar.x)], 1u); xbar.st[4] = xbar.x + 8u * rank; xbar.st[5] = 0u; }
    __syncthreads();

#ifndef PROBE_DUP
#define PROBE_DUP 0u
#endif
    int rep = 0;
#pragma unroll 1
    for (int ph = ph_lo; ph < ph_hi;) {
        int tid = threadIdx.x; asm volatile("" : "+v"(tid));
        const int lane = tid & 63, wave = __builtin_amdgcn_readfirstlane(tid >> 6);
        int G = gridDim.x, bx = blockIdx.x; asm volatile("" : "+s"(G), "+s"(bx));
        const int bxg = __builtin_amdgcn_readfirstlane(xbar.st[5] ? (int)xbar.st[4] : bx);
        const int gw = bx * NWAVES + wave, NGW = G * NWAVES;
        unsigned char* ws = KARG_WS();
        unsigned char* wb = (unsigned char*)KARG_OUT();
        bf16_t* XN = (bf16_t*)(ws + WS_XN); bf16_t* BIG = (bf16_t*)(ws + WS_BIG); bf16_t* AB = (bf16_t*)(ws + WS_AB);
        float* SSP = (float*)(ws + WS_SSP);
        if (ph == 0) {
#ifndef NO_P0
            p0_phase(wb, lds, gw, NGW, wave, lane, bx * NTHREADS + tid, G * NTHREADS);
#endif
            convert_phase(KARG_IN(0), KARG_IN(1), XN, SSP, gw, NGW, lane);
        } else if (ph == 1 || ph == 6 || ph == 8 || ph == 16) {
#ifndef NO_G1
            const int f = ph == 1 ? 0 : ph == 6 ? 1 : ph == 8 ? 2 : 3;
            pg8::Gemm g{XN, (const bf16_t*)(wb + WS_WGU + f * WGU_STRIDE), MT, 2 * DFF, DM, 1}; pg8::StaticOrder S; S.init(MT, 2 * DFF, G, bxg);
            precompute_rl(lds, S, SSP, tid);
            pg8::EpiSwiGLU E{BIG, DFF, (const LAS float*)(lds + RL_OFF)};
            pg8::gemm_phase<pg8::EpiSwiGLU, pg8::StaticOrder, true, true>(lds, g, S, E);
#endif
        } else if (ph == 2 || ph == 7 || ph == 9 || ph == 17 || ph == 5 || ph == 12 || ph == 15) {
#ifndef NO_G2
            const bool ffn = !(ph == 5 || ph == 12 || ph == 15);
            const int f = ph == 2 ? 0 : ph == 7 ? 1 : ph == 9 ? 2 : 3;
            const int M = (ph == 12 || ph == 15) ? MH : MT;
            const size_t rb = ph == 15 ? (size_t)MH : 0;
            const bf16_t* A = ffn ? BIG : (ph == 5 ? AB : BIG  );
            const bf16_t* Bt = ffn ? (const bf16_t*)(wb + WS_WD + f * WD_STRIDE) : (const bf16_t*)(wb + (ph == 5 ? WS_WOUT0 : WS_WOUT1));
            pg8::Gemm g{A, Bt, M, DM, ffn ? DFF : DM, 1  }; pg8::StaticOrder S; S.init(M, DM, G, bxg);
            bf16_t* xb = XN + rb * DM;
            pg8::EpiResidual E{ffn ? 0.5f : 1.0f, xb, SSP + rb * 16, (PROBE_DUP != 0u && rep == 0 && ((PROBE_DUP >> ph) & 1u)) ? (bf16_t*)(ws + WS_END) : xb};
            pg8::gemm_phase<pg8::EpiResidual, pg8::StaticOrder, true, true>(lds, g, S, E);
#endif
        } else if (ph == 3 || ph == 10 || ph == 13) {
#ifndef NO_G3
            const int N = ph == 3 ? ZW : QKVW, M = ph == 3 ? MT : MH;
            const size_t rb = ph == 13 ? (size_t)MH : 0;
            pg8::Gemm g{XN + rb * DM, (const bf16_t*)(wb + (ph == 3 ? WS_WIN : WS_WQKV)), M, N, DM, 1}; pg8::StaticOrder S; S.init(M, N, G, bxg);
            precompute_rl(lds, S, SSP + rb * 16, tid);
            pg8::EpiBf16G E{BIG, ph == 3 ? ZW : DM, ph == 3 ? 4 : 0, (const LAS float*)(lds + RL_OFF), ph == 3 ? 1000 : 4, (bf16_t*)(ws + WS_KV), 2048};
            pg8::gemm_phase<pg8::EpiBf16G, pg8::StaticOrder, true, true>(lds, g, S, E);
#endif
        } else if (ph == 4) {
            const float* rc = (const float*)(wb + WS_ROPE_C); const float* rs = (const float*)(wb + WS_ROPE_S);
            constexpr int nchunks = MT / 128;
#ifndef NO_SWA
#pragma unroll 1
            for (int idx = bx; idx < 2 * nchunks; idx += G) {
                const int chunk = idx >> 1, g = idx & 1, hf = chunk >= 256, cl = chunk & 255, L = hf ? 2048 : 4096, nb = L / 128;
                swa_unit(lds, BIG, AB, rc, rs, KARG_IN(12), hf ? MH : 0, cl / nb, cl % nb, g, L, tid);
            }
#endif
#ifndef NO_SGU
#pragma unroll 1
            for (int idx = bx; idx < nchunks; idx += G) sgu_unit(lds, BIG, AB, (const bf16_t*)(wb + WS_SGUW), KARG_IN(11), KARG_IN(8), KARG_IN(9), idx * 128, tid);
#endif
        } else if (ph == 11 || ph == 14) {
#ifndef NO_NA
            const int L = ph == 14 ? 2048 : 4096;
            const int nrg = L / 256, nunits = (MH / L) * 16 * nrg;
#pragma unroll 1
            for (int idx = bx; idx < nunits; idx += G) { const int hh = idx & 15, rg = (idx >> 4) % nrg, b = (idx >> 4) / nrg; na_unit(lds, BIG, (const bf16_t*)(ws + WS_KV), KARG_IN(24), b, hh, rg, L, tid); }
#endif
        } else {
            final_norm_phase(XN, KARG_OUT(), SSP, KARG_IN(30), gw, NGW, lane);
        }
        if (PROBE_DUP != 0u && rep == 0 && ((PROBE_DUP >> ph) & 1u)) { rep = 1; xcd_barrier(xbar); continue; }
        rep = 0;
        if (ph + 1 < ph_hi) {
            if (ph == 0) {
                grid.sync();
                if (threadIdx.x == 0) {
                    const unsigned Gn = gridDim.x; unsigned even = (Gn % 8u == 0u) ? 1u : 0u;
                    for (unsigned j = 0; j < 16; ++j) { const unsigned cnt = xb_ld(&xbar.bar[XB_XCNT(j)]); if (cnt != (j < 8 ? Gn / 8u : 0u)) even = 0u; }
                    xbar.st[5] = even;
                }
                __syncthreads();
            } else xcd_barrier(xbar);
        }
        ++ph;
    }
}

extern "C" void kernel_launch(void* const* d_in, const int* in_sizes, int n_in, void* d_out, int out_size, void* d_ws, size_t ws_size, hipStream_t stream) {
    static int grid = 0;
    if (grid == 0) {
        if (n_in != 31 || out_size != MT * DM || ws_size < WS_END) { fprintf(stderr, "kernel_launch: unexpected shapes (n_in %d out %d ws %zu)\n", n_in, out_size, ws_size); grid = -1; return; }
        int dev = 0, cus = 0, per_cu = 0;
        hipGetDevice(&dev); hipDeviceGetAttribute(&cus, hipDeviceAttributeMultiprocessorCount, dev);
        if (hipFuncSetAttribute((const void*)fwd_megakernel, hipFuncAttributeMaxDynamicSharedMemorySize, LDS_BYTES) != hipSuccess) { fprintf(stderr, "kernel_launch: hipFuncSetAttribute failed\n"); grid = -1; return; }
        if (hipOccupancyMaxActiveBlocksPerMultiprocessor(&per_cu, (const void*)fwd_megakernel, NTHREADS, LDS_BYTES) != hipSuccess || per_cu < 1) { fprintf(stderr, "kernel_launch: occupancy query says %d\n", per_cu); per_cu = 1; }
        (void)hipGetLastError();
        grid = cus * per_cu;
        fprintf(stderr, "kernel_launch: grid %d (cus %d x %d)\n", grid, cus, per_cu);
    }
    if (grid < 0) return;
    if (hipMemsetAsync((char*)d_ws + WS_CTL, 0, 65536, stream) != hipSuccess) { fprintf(stderr, "kernel_launch: memset failed\n"); return; }
    Args a{};
    for (int i = 0; i < 31; ++i) a.in[i] = (const float*)d_in[i];
    a.out = (float*)d_out; a.ws = (unsigned char*)d_ws;
#if MK_SINGLE
    a.ph_lo = 0; a.ph_hi = NPHASES;
    void* kargs[] = {&a};
    hipError_t e = hipLaunchCooperativeKernel((const void*)fwd_megakernel, dim3(grid), dim3(NTHREADS), kargs, LDS_BYTES, stream);
    if (e != hipSuccess) fprintf(stderr, "cooperative launch failed: %s (grid %d)\n", hipGetErrorString(e), grid);
#else
    for (int ph = 0; ph < NPHASES; ++ph) {
        a.ph_lo = ph; a.ph_hi = ph + 1;
        hipLaunchKernelGGL(fwd_megakernel, dim3(grid), dim3(NTHREADS), LDS_BYTES, stream, a);
    }
#endif
}
```

```cpp
#include <hip/hip_runtime.h>
#include <hip/hip_cooperative_groups.h>
#include <cstdio>
#include <cstdint>
namespace cg = cooperative_groups;

#ifndef MK_SINGLE
#define MK_SINGLE 1
#endif

#define GAS __attribute__((address_space(1)))
namespace pg8 {
#define PG8_LAS __attribute__((address_space(3)))
typedef unsigned short bf16_t;
typedef short bf16x8 __attribute__((ext_vector_type(8)));
typedef float f32x4 __attribute__((ext_vector_type(4)));
typedef unsigned u32x4 __attribute__((ext_vector_type(4)));
constexpr int BM = 256, BK = 64, HALF = 128, HTB = HALF * BK * 2  , STAGE_BYTES = 8 * HTB, NXCD = 8, WGM = 8;

__host__ __device__ __forceinline__ int lds_byte(int r, int c) { const int st = (r >> 4) * 2 + (c >> 5), rr = r & 15, cc = c & 31, ob = rr * 64 + cc * 2; return st * 1024 + (ob ^ (((ob >> 9) & 1) << 5)); }
__host__ __device__ __forceinline__ void stage_rc(int b, int& R, int& C) { const int st = b / 1024, sb = b % 1024, swz = sb ^ (((sb >> 9) & 1) << 5); R = (st >> 1) * 16 + swz / 64; C = (st & 1) * 32 + (swz % 64) / 2; }
__host__ __device__ __forceinline__ int perm32(int rho) { const int n = rho >> 4, i = rho & 15; return 8 * (i >> 2) + 4 * n + (i & 3); }

struct Unit { int pm, pn; };
struct Gemm { const bf16_t* A; const bf16_t* Bt; int M, N, K; int tiledA; };

struct StaticOrder {
    int nM, nN, nwg, G, c;
    __host__ __device__ void init(int M, int N, int G_, int c_) { nM = M / BM; nN = N / BM; nwg = nM * nN; G = G_; c = c_; }
    __host__ __device__ bool next(int i, Unit& u) const {
        const long L = (long)i * G + c; if (L >= nwg) return false;
        int wgid = (int)L; { const int q = nwg / NXCD, r = nwg % NXCD, xcd = wgid % NXCD, off = wgid / NXCD; wgid = (xcd < r ? xcd * (q + 1) : r * (q + 1) + (xcd - r) * q) + off; }
        const int nig = WGM * nN, gid = wgid / nig, fm = gid * WGM, gsz = (nM - fm) < WGM ? (nM - fm) : WGM;
        u.pm = fm + ((wgid % nig) % gsz); u.pn = (wgid % nig) / gsz; return true;
    }
    __device__ __forceinline__ void a_ready(const Unit&) const {}
    __device__ __forceinline__ void done(const Unit&) const {}
};
__device__ __forceinline__ unsigned cvt_pk_bf16(float lo, float hi) { unsigned r; asm volatile("v_cvt_pk_bf16_f32 %0, %1, %2" : "=v"(r) : "v"(lo), "v"(hi)); return r; }
typedef float f32x2 __attribute__((ext_vector_type(2)));
__device__ __forceinline__ f32x2 gelu_pk(f32x2 v) {
    const f32x2 av = __builtin_elementwise_abs(v), d = av * 0.2316418882f + 1.0f;
    f32x2 t; t.x = __builtin_amdgcn_rcpf(d.x); t.y = __builtin_amdgcn_rcpf(d.y);
    f32x2 q = t * 0.5307027145f + (-0.7265760135f); q = q * t + 0.7107068705f; q = q * t + (-0.142248368f); q = q * t + 0.127414796f; q = q * t;
    const f32x2 s = (v * v) * (-0.72134752044f);
    f32x2 e; e.x = __builtin_amdgcn_exp2f(s.x); e.y = __builtin_amdgcn_exp2f(s.y);
    const f32x2 m = v * (q * e), r = v - m;
    f32x2 o; o.x = v.x < 0.f ? m.x : r.x; o.y = v.y < 0.f ? m.y : r.y; return o;
}

__device__ __forceinline__ unsigned pk_bf16(float lo, float hi) { typedef __bf16 bf2 __attribute__((ext_vector_type(2))); f32x2 v = {lo, hi}; bf2 b = __builtin_convertvector(v, bf2); return __builtin_bit_cast(unsigned, b); }
__device__ __forceinline__ float silu_mul(float g, float u) { return g * __builtin_amdgcn_rcpf(1.0f + __builtin_amdgcn_exp2f(-1.4426950408889634f * g)) * u; }

struct EpiSwiGLU {
    static constexpr bool PERM = true, AFTER_DRAIN = false;
    bf16_t* H; int ldh; const PG8_LAS float* rl;
    __device__ __forceinline__ void operator()(const f32x4 (&acc)[2][2][4][2], const Unit& u, int wr, int wc, int fr, int fq, int ui) const {
        const int row0 = u.pm * BM + wr * 64 + fr, col0 = u.pn * HALF + wc * 32 + 8 * fq;
        const PG8_LAS float* rp = rl + ui * 256 + wr * 64 + fr;
#pragma unroll
        for (int ai = 0; ai < 2; ++ai)
#pragma unroll
            for (int m = 0; m < 4; ++m) {
                bf16_t* p = H + ((size_t)(2 * u.pm + ai) * (ldh >> 5) + 4 * u.pn + wc) * 4096 + (wr * 64 + m * 16 + fr) * 32 + 8 * fq;
                const float rr = rp[ai * HALF + m * 16], c1 = -1.4426950408889634f * rr, c2 = rr * rr;
                f32x4 hv[2];
#pragma unroll
                for (int n = 0; n < 2; ++n) {
                    const f32x4 g = acc[ai][0][m][n], uu = acc[ai][1][m][n];
                    f32x4 e = g * c1;
                    e = (f32x4){__builtin_amdgcn_exp2f(e[0]), __builtin_amdgcn_exp2f(e[1]), __builtin_amdgcn_exp2f(e[2]), __builtin_amdgcn_exp2f(e[3])};
                    const f32x4 d = e + 1.0f;
                    const f32x4 r = {__builtin_amdgcn_rcpf(d[0]), __builtin_amdgcn_rcpf(d[1]), __builtin_amdgcn_rcpf(d[2]), __builtin_amdgcn_rcpf(d[3])};
                    hv[n] = (g * uu) * (r * c2);
                }
                u32x4 w;
                w.x = pk_bf16(hv[0][0], hv[0][1]); w.y = pk_bf16(hv[0][2], hv[0][3]); w.z = pk_bf16(hv[1][0], hv[1][1]); w.w = pk_bf16(hv[1][2], hv[1][3]);
                __builtin_nontemporal_store(w, (GAS u32x4*)p);
            }
    }
};
struct EpiResidual {
    static constexpr bool PERM = true, AFTER_DRAIN = false;
    float scale; bf16_t* XB; float* SSP; bf16_t* XBo;
    __device__ __forceinline__ void operator()(const f32x4 (&acc)[2][2][4][2], const Unit& u, int wr, int wc, int fr, int fq, int ui) const {
        const int row0 = u.pm * BM + wr * 64 + fr;
#pragma unroll
        for (int ai = 0; ai < 2; ++ai) {
            u32x4 xb[4][2];
#pragma unroll
            for (int m = 0; m < 4; ++m)
#pragma unroll
                for (int bj = 0; bj < 2; ++bj) xb[m][bj] = *(const GAS u32x4*)(XB + ((size_t)(2 * u.pm + ai) * 32 + 8 * u.pn + 4 * bj + wc) * 4096 + (wr * 64 + m * 16 + fr) * 32 + 8 * fq);
#pragma unroll
            for (int m = 0; m < 4; ++m) {
                const int row = row0 + ai * HALF + m * 16;
                float ss = 0.f;
#pragma unroll
                for (int bj = 0; bj < 2; ++bj) {
                    const u32x4 b = xb[m][bj];
                    const f32x4 a0 = {__builtin_bit_cast(float, b.x << 16), __builtin_bit_cast(float, b.x & 0xffff0000u), __builtin_bit_cast(float, b.y << 16), __builtin_bit_cast(float, b.y & 0xffff0000u)};
                    const f32x4 a1 = {__builtin_bit_cast(float, b.z << 16), __builtin_bit_cast(float, b.z & 0xffff0000u), __builtin_bit_cast(float, b.w << 16), __builtin_bit_cast(float, b.w & 0xffff0000u)};
                    const f32x4 o0 = a0 + acc[ai][bj][m][0] * scale, o1 = a1 + acc[ai][bj][m][1] * scale;
                    { const f32x4 q = o0 * o0 + o1 * o1; ss += (q[0] + q[1]) + (q[2] + q[3]); }
                    u32x4 w; w.x = pk_bf16(o0[0], o0[1]); w.y = pk_bf16(o0[2], o0[3]); w.z = pk_bf16(o1[0], o1[1]); w.w = pk_bf16(o1[2], o1[3]);
                    *(GAS u32x4*)(XBo + ((size_t)(2 * u.pm + ai) * 32 + 8 * u.pn + 4 * bj + wc) * 4096 + (wr * 64 + m * 16 + fr) * 32 + 8 * fq) = w;
                }
                { const unsigned sb = __builtin_bit_cast(unsigned, ss); auto r16 = __builtin_amdgcn_permlane16_swap(sb, sb, false, false);
                  ss = __builtin_bit_cast(float, (unsigned)r16[0]) + __builtin_bit_cast(float, (unsigned)r16[1]);
                  const unsigned sc = __builtin_bit_cast(unsigned, ss); auto r32 = __builtin_amdgcn_permlane32_swap(sc, sc, false, false);
                  ss = __builtin_bit_cast(float, (unsigned)r32[0]) + __builtin_bit_cast(float, (unsigned)r32[1]); }
                if (fq == 0) ((GAS float*)SSP)[(size_t)row * 16 + u.pn * 4 + wc] = ss;
            }
        }
    }
};
struct EpiBf16G {
    static constexpr bool PERM = true, AFTER_DRAIN = false;
    bf16_t* O; int ldc; int gelu_tiles; const PG8_LAS float* rl; int split_tiles; bf16_t* O2; int ldc2;
    __device__ __forceinline__ void operator()(const f32x4 (&acc)[2][2][4][2], const Unit& u, int wr, int wc, int fr, int fq, int ui) const {
        const bool second = u.pn >= split_tiles;
        bf16_t* const Ob = second ? O2 : O; const int ld = second ? ldc2 : ldc;
        const int pnl = second ? u.pn - split_tiles : u.pn, nslab = ld >> 5;
        const PG8_LAS float* rp = rl + ui * 256 + wr * 64 + fr;
        const bool act = u.pn < gelu_tiles;
#pragma unroll
        for (int ai = 0; ai < 2; ++ai)
#pragma unroll
            for (int m = 0; m < 4; ++m) {
                bf16_t* rowp = Ob + ((size_t)(2 * u.pm + ai) * nslab + 8 * pnl + wc) * 4096 + (wr * 64 + m * 16 + fr) * 32 + 8 * fq;
                const float rr = rp[ai * HALF + m * 16];
#pragma unroll
                for (int bj = 0; bj < 2; ++bj) {
                    f32x4 v0 = acc[ai][bj][m][0] * rr, v1 = acc[ai][bj][m][1] * rr;
                    if (act) { f32x2 a = gelu_pk((f32x2){v0[0], v0[1]}), b = gelu_pk((f32x2){v0[2], v0[3]}), c = gelu_pk((f32x2){v1[0], v1[1]}), d = gelu_pk((f32x2){v1[2], v1[3]});
                        v0 = (f32x4){a.x, a.y, b.x, b.y}; v1 = (f32x4){c.x, c.y, d.x, d.y}; }
                    u32x4 w; w.x = pk_bf16(v0[0], v0[1]); w.y = pk_bf16(v0[2], v0[3]); w.z = pk_bf16(v1[0], v1[1]); w.w = pk_bf16(v1[2], v1[3]);
                    __builtin_nontemporal_store(w, (GAS u32x4*)(rowp + bj * 4 * 4096));
                }
            }
    }
};

template <class Epi, class Sched, bool ALIGN_EPI = false, bool SP2 = false>
__device__ __forceinline__ void gemm_phase(PG8_LAS unsigned char* lds, const Gemm g, const Sched& S, const Epi& E) {
    int tid = threadIdx.x; asm volatile("" : "+v"(tid));
    const int wid = __builtin_amdgcn_readfirstlane(tid >> 6), lane = tid & 63, wr = wid >> 2, wc = wid & 3, fr = lane & 15, fq = lane >> 4;
    const int K = g.K, nt = K / BK;
    unsigned voffA[2], voffB[2];
#pragma unroll
    for (int i = 0; i < 2; ++i) { int R, C; stage_rc(tid * 16 + i * 8192, R, C); const int Rb = Epi::PERM ? ((R & ~31) + perm32(R & 31)) : R;
        voffA[i] = g.tiledA ? (unsigned)((C >> 5) * 8192 + R * 64 + (C & 31) * 2) : (unsigned)(R * K + C) * 2u; voffB[i] = (unsigned)(Rb * K + C) * 2u; }
    const size_t kstep = (size_t)(BK * 2);
    const size_t kstepA = g.tiledA ? (size_t)16384 : kstep;
    const size_t hstep = (size_t)HALF * K * 2;
    const size_t tstep = 2 * hstep;
    const unsigned ldsw = (unsigned)wid * 1024u;
    const int aoff = lds_byte(wr * 64 + fr, fq * 8), boff = lds_byte(wc * 32 + fr, fq * 8);
#define PG8_SA(b, h) (((b) * 2 + (h)) * HTB)
#define PG8_SB(b, h) ((4 + (b) * 2 + (h)) * HTB)
#define PG8_STAGE(bufoff, gbase, voff) do { _Pragma("unroll") for (int _i = 0; _i < 2; ++_i) \
        __builtin_amdgcn_global_load_lds((const unsigned*)((const char*)(gbase) + (voff)[_i]), (PG8_LAS unsigned*)(lds + (bufoff) + ldsw + _i * 8192), 16, 0, 0); } while (0)
#define PG8_LDA(dst, b, h) do { _Pragma("unroll") for (int m = 0; m < 4; ++m) _Pragma("unroll") for (int k = 0; k < 2; ++k) dst[m][k] = *(const PG8_LAS bf16x8*)(lds + PG8_SA(b, h) + aoff + m * 2048 + k * 1024); } while (0)
#define PG8_LDB(dst, b, h) do { _Pragma("unroll") for (int n = 0; n < 2; ++n) _Pragma("unroll") for (int k = 0; k < 2; ++k) dst[n][k] = *(const PG8_LAS bf16x8*)(lds + PG8_SB(b, h) + boff + n * 2048 + k * 1024); } while (0)
#define PG8_MMA(ai, bj, At, Bt) do { __builtin_amdgcn_s_setprio(1); _Pragma("unroll") for (int m = 0; m < 4; ++m) _Pragma("unroll") for (int n = 0; n < 2; ++n) _Pragma("unroll") for (int k = 0; k < 2; ++k) \
        acc[ai][bj][m][n] = __builtin_amdgcn_mfma_f32_16x16x32_bf16(Bt[n][k], At[m][k], acc[ai][bj][m][n], 0, 0, 0); __builtin_amdgcn_s_setprio(0); } while (0)
#define PG8_WAIT_V(n) asm volatile("s_waitcnt vmcnt(" #n ")" ::: "memory")
#define PG8_WAIT_L(n) asm volatile("s_waitcnt lgkmcnt(" #n ")" ::: "memory")
#define PG8_BAR __builtin_amdgcn_s_barrier()
#define PG8_SCHED __builtin_amdgcn_sched_barrier(0)
    Unit cur, nxt; int ui = 0;
    if (!S.next(0, cur)) return;
    f32x4 acc[2][2][4][2];
#pragma unroll
    for (int a = 0; a < 2; ++a)
#pragma unroll
        for (int b = 0; b < 2; ++b)
#pragma unroll
            for (int m = 0; m < 4; ++m)
#pragma unroll
                for (int n = 0; n < 2; ++n) acc[a][b][m][n] = (f32x4){0.f, 0.f, 0.f, 0.f};
    bf16x8 At[4][2], B0[2][2], B1[2][2];
    const char* cA = (const char*)g.A + (size_t)cur.pm * tstep; const char* cB = (const char*)g.Bt + (size_t)cur.pn * tstep;
    S.a_ready(cur);
    if constexpr (SP2) {
        PG8_STAGE(PG8_SB(0, 0), cB, voffB); PG8_STAGE(PG8_SB(0, 1), cB + hstep, voffB); PG8_STAGE(PG8_SA(0, 0), cA, voffA); PG8_STAGE(PG8_SA(0, 1), cA + hstep, voffA);
        if (wr == 1) PG8_BAR;
        PG8_WAIT_V(2); PG8_BAR;
        PG8_STAGE(PG8_SB(1, 0), cB + kstep, voffB); PG8_STAGE(PG8_SA(1, 0), cA + kstepA, voffA); PG8_STAGE(PG8_SB(1, 1), cB + hstep + kstep, voffB);
        PG8_WAIT_V(6); PG8_BAR;
    } else {
        PG8_STAGE(PG8_SB(0, 0), cB, voffB); PG8_STAGE(PG8_SA(0, 0), cA, voffA); PG8_STAGE(PG8_SB(0, 1), cB + hstep, voffB); PG8_STAGE(PG8_SA(0, 1), cA + hstep, voffA);
        if (wr == 1) PG8_BAR;
        PG8_WAIT_V(4); PG8_BAR;
        PG8_STAGE(PG8_SB(1, 0), cB + kstep, voffB); PG8_STAGE(PG8_SA(1, 0), cA + kstepA, voffA); PG8_STAGE(PG8_SB(1, 1), cB + hstep + kstep, voffB);
        PG8_WAIT_V(6); PG8_BAR;
    }
    for (;;) {
        const bool has_next = S.next(ui + 1, nxt);
        const char* nA = has_next ? (const char*)g.A + (size_t)nxt.pm * tstep : cA; const char* nB = has_next ? (const char*)g.Bt + (size_t)nxt.pn * tstep : cB;
        for (int t = 0; t < nt; t += 2) {
            const bool last = (t == nt - 2);
            const char* a1 = cA + (size_t)(t + 1) * kstepA;
            const char* a2 = last ? nA : cA + (size_t)(t + 2) * kstepA; const char* b2 = last ? nB : cB + (size_t)(t + 2) * kstep;
            const char* a3 = a2 + kstepA; const char* b3 = b2 + kstep;
            if (last && has_next) S.a_ready(nxt);
            if constexpr (SP2) {
            PG8_LDB(B0, 0, 0); PG8_LDB(B1, 0, 1); PG8_SCHED; PG8_LDA(At, 0, 0); PG8_STAGE(PG8_SA(1, 1), a1 + hstep, voffA);
            PG8_WAIT_V(8); PG8_WAIT_L(0); PG8_BAR; PG8_MMA(0, 0, At, B0); PG8_MMA(0, 1, At, B1); PG8_BAR; PG8_SCHED;
            PG8_LDA(At, 0, 1); PG8_STAGE(PG8_SB(0, 0), b2, voffB); PG8_STAGE(PG8_SB(0, 1), b2 + hstep, voffB); PG8_STAGE(PG8_SA(0, 0), a2, voffA);
            PG8_WAIT_V(8); PG8_WAIT_L(0); PG8_BAR; PG8_MMA(1, 0, At, B0); PG8_MMA(1, 1, At, B1); PG8_BAR; PG8_SCHED;
            PG8_LDB(B0, 1, 0); PG8_LDB(B1, 1, 1); PG8_SCHED; PG8_LDA(At, 1, 0); PG8_STAGE(PG8_SA(0, 1), a2 + hstep, voffA);
            PG8_WAIT_V(8); PG8_WAIT_L(0); PG8_BAR; PG8_MMA(0, 0, At, B0); PG8_MMA(0, 1, At, B1); PG8_BAR; PG8_SCHED;
            PG8_LDA(At, 1, 1); PG8_STAGE(PG8_SB(1, 0), b3, voffB); PG8_STAGE(PG8_SB(1, 1), b3 + hstep, voffB); PG8_STAGE(PG8_SA(1, 0), a3, voffA);
            PG8_WAIT_V(8); PG8_WAIT_L(0); PG8_BAR; PG8_MMA(1, 0, At, B0); PG8_MMA(1, 1, At, B1); PG8_BAR; PG8_SCHED;
            } else {
            PG8_LDB(B0, 0, 0); PG8_SCHED; PG8_LDA(At, 0, 0); PG8_STAGE(PG8_SA(1, 1), a1 + hstep, voffA);
            PG8_WAIT_L(8); PG8_BAR; PG8_WAIT_L(0); PG8_MMA(0, 0, At, B0); PG8_BAR; PG8_SCHED;
            PG8_LDB(B1, 0, 1); PG8_STAGE(PG8_SB(0, 0), b2, voffB);
            PG8_BAR; PG8_WAIT_L(0); PG8_MMA(0, 1, At, B1); PG8_BAR;
            PG8_LDA(At, 0, 1); PG8_STAGE(PG8_SA(0, 0), a2, voffA);
            PG8_BAR; PG8_WAIT_L(0); PG8_MMA(1, 0, At, B0); PG8_BAR; PG8_SCHED;
            PG8_STAGE(PG8_SB(0, 1), b2 + hstep, voffB);
            PG8_WAIT_V(6); PG8_BAR; PG8_MMA(1, 1, At, B1); PG8_BAR;
            PG8_LDB(B0, 1, 0); PG8_SCHED; PG8_LDA(At, 1, 0); PG8_STAGE(PG8_SA(0, 1), a2 + hstep, voffA);
            PG8_WAIT_L(8); PG8_BAR; PG8_WAIT_L(0); PG8_MMA(0, 0, At, B0); PG8_BAR; PG8_SCHED;
            PG8_LDB(B1, 1, 1); PG8_STAGE(PG8_SB(1, 0), b3, voffB);
            PG8_BAR; PG8_WAIT_L(0); PG8_MMA(0, 1, At, B1); PG8_BAR;
            PG8_LDA(At, 1, 1); PG8_STAGE(PG8_SA(1, 0), a3, voffA);
            PG8_BAR; PG8_WAIT_L(0); PG8_MMA(1, 0, At, B0); PG8_BAR; PG8_SCHED;
            PG8_STAGE(PG8_SB(1, 1), b3 + hstep, voffB);
            PG8_WAIT_V(6); PG8_BAR; PG8_MMA(1, 1, At, B1); PG8_BAR;
            }
        }
        if constexpr (ALIGN_EPI) { if (wr == 0) PG8_BAR; }
        if constexpr (!Epi::AFTER_DRAIN) { E(acc, cur, wr, wc, fr, fq, ui); S.done(cur); }
        if (!has_next) break;
#pragma unroll
        for (int a = 0; a < 2; ++a)
#pragma unroll
            for (int b = 0; b < 2; ++b)
#pragma unroll
                for (int m = 0; m < 4; ++m)
#pragma unroll
                    for (int n = 0; n < 2; ++n) acc[a][b][m][n] = (f32x4){0.f, 0.f, 0.f, 0.f};
        cur = nxt; cA = nA; cB = nB; ++ui;
        if constexpr (ALIGN_EPI) { if (wr == 1) PG8_BAR; }
    }
    PG8_WAIT_V(0);
    if constexpr (!ALIGN_EPI) { if (wr == 0) PG8_BAR; }
    PG8_BAR;
    if constexpr (Epi::AFTER_DRAIN) { E.fused(acc, cur, wr, wc, fr, fq, lds, wid, lane); S.done(cur); }
#undef PG8_SA
#undef PG8_SB
#undef PG8_STAGE
#undef PG8_LDA
#undef PG8_LDB
#undef PG8_MMA
#undef PG8_WAIT_V
#undef PG8_WAIT_L
#undef PG8_BAR
#undef PG8_SCHED
}
}

#define DI __device__ __forceinline__
#define LAS __attribute__((address_space(3)))
typedef unsigned short bf16_t;
typedef short bf16x8 __attribute__((ext_vector_type(8)));
typedef short s16x4 __attribute__((ext_vector_type(4)));
typedef float f32x4 __attribute__((ext_vector_type(4)));
typedef float f32x2 __attribute__((ext_vector_type(2)));
typedef float f32x16 __attribute__((ext_vector_type(16)));
typedef unsigned u32x4 __attribute__((ext_vector_type(4)));
typedef unsigned u32x2 __attribute__((ext_vector_type(2)));
using pg8::pk_bf16;

constexpr int NWAVES = 8, NTHREADS = 512;
constexpr int DM = 1024, DFF = 2816, MH = 32768;
constexpr int ZW = 1792, QKVW = 3072;
constexpr float EPS = 1e-6f, LOG2E = 1.4426950408889634f, C2 = 0.125f * 1.4426950408889634f;
constexpr size_t MiB = 1u << 20;
constexpr int MT = 2 * MH;
constexpr size_t WS_ROPE_C = 1 * MiB, WS_ROPE_S = 1 * MiB + 131072, WS_SGUW = 1 * MiB + 524288;
constexpr size_t WS_WGU = 2 * MiB, WGU_STRIDE = 11 * MiB;
constexpr size_t WS_WD = 46 * MiB, WD_STRIDE = 5 * MiB + 524288;
constexpr size_t WS_WIN = 68 * MiB, WS_WOUT0 = 72 * MiB, WS_WQKV = 74 * MiB, WS_WOUT1 = 80 * MiB;
constexpr size_t WS_XN = 0;
constexpr size_t WS_BIG = 128 * MiB;
constexpr size_t WS_AB = WS_BIG + 224 * MiB;
constexpr size_t WS_KV = WS_BIG + 64 * MiB;
constexpr size_t WS_CTL = 480 * MiB;
constexpr size_t WS_SSP = 481 * MiB;
constexpr size_t WS_END = 485 * MiB;
constexpr int RL_OFF = 131072, RL_UNITS = 24;
constexpr int MISC_OFF = RL_OFF + RL_UNITS * 1024;
constexpr int LDS_BYTES = MISC_OFF + 64;
constexpr int NPHASES = 19;

DI float bf2f(unsigned short v) { return __builtin_bit_cast(float, (unsigned)v << 16); }
DI float bflo(unsigned v) { return __builtin_bit_cast(float, v << 16); }
DI float bfhi(unsigned v) { return __builtin_bit_cast(float, v & 0xffff0000u); }
DI float wave_sum(float v) {
#pragma unroll
    for (int o = 1; o < 64; o <<= 1) v += __shfl_xor(v, o);
    return v;
}
DI int clampi(int v, int lo, int hi) { return v < lo ? lo : (v > hi ? hi : v); }
DI int crow(int reg, int h) { return (reg & 3) + 8 * (reg >> 2) + 4 * h; }
DI size_t toff(size_t row, int col, int nslab) { return ((row >> 7) * nslab + (col >> 5)) * 4096 + (row & 127) * 32 + (col & 31); }
#define LDS_BARRIER() do { asm volatile("s_waitcnt lgkmcnt(0)" ::: "memory"); __builtin_amdgcn_s_barrier(); asm volatile("" ::: "memory"); } while (0)
#define MFMA32(a, b, c) __builtin_amdgcn_mfma_f32_32x32x16_bf16((a), (b), (c), 0, 0, 0)
DI s16x4 tr_read(LAS const char* p) { return __builtin_bit_cast(s16x4, __builtin_amdgcn_ds_read_tr16_b64_v4i16((LAS s16x4*)p)); }
DI bf16x8 pack8(const f32x16& x, int s) {
    u32x4 p; p.x = pk_bf16(x[8 * s], x[8 * s + 1]); p.y = pk_bf16(x[8 * s + 2], x[8 * s + 3]); p.z = pk_bf16(x[8 * s + 4], x[8 * s + 5]); p.w = pk_bf16(x[8 * s + 6], x[8 * s + 7]);
    return __builtin_bit_cast(bf16x8, p);
}

DI void p0_transpose_item(const float* W, int K, int N, bf16_t* WT, int mode, LAS float* scr, int item, int lane, const float* gain = nullptr) {
    const int nblk = N / 32, kb = item / nblk, nb = item % nblk, k0 = 64 * kb, n0 = 32 * nb;
    const int drow0 = mode == 0 ? n0 : (256 * (n0 >> 7) + (n0 & 127) + (mode == 2 ? 128 : 0));
#pragma unroll 8
    for (int i = 0; i < 32; ++i) { const int kk = 2 * i + (lane >> 5); scr[kk * 33 + (lane & 31)] = ((const GAS float*)W)[(size_t)(k0 + kk) * N + n0 + (lane & 31)]; }
    asm volatile("s_waitcnt lgkmcnt(0)" ::: "memory");
    const int c = lane & 7;
    f32x4 ga = {1.f, 1.f, 1.f, 1.f}, gb = ga;
    if (gain) { ga = *(const GAS f32x4*)(gain + k0 + 8 * c); gb = *(const GAS f32x4*)(gain + k0 + 8 * c + 4); }
#pragma unroll
    for (int j = 0; j < 4; ++j) { const int n = (lane >> 3) + 8 * j; const LAS float* s = scr + (8 * c) * 33 + n;
        u32x4 o; o.x = pk_bf16(s[0 * 33] * ga.x, s[1 * 33] * ga.y); o.y = pk_bf16(s[2 * 33] * ga.z, s[3 * 33] * ga.w); o.z = pk_bf16(s[4 * 33] * gb.x, s[5 * 33] * gb.y); o.w = pk_bf16(s[6 * 33] * gb.z, s[7 * 33] * gb.w);
        *(GAS u32x4*)(WT + (size_t)(drow0 + n) * K + k0 + 8 * c) = o; }
    asm volatile("s_waitcnt lgkmcnt(0)" ::: "memory");
}

struct Args { const float* in[31]; float* out; unsigned char* ws; int ph_lo, ph_hi; };

typedef const __attribute__((address_space(4))) char* kargp0_t;
#define A_IN(k) ((const float*)(*(const unsigned long long volatile __attribute__((address_space(4)))*)((kargp0_t)__builtin_amdgcn_kernarg_segment_ptr() + 8 * (k))))
DI void p0_phase(unsigned char* ws  , LAS unsigned char* lds, int gw, int NGW, int wave, int lane, int gtid, int gthreads) {
    LAS float* scr = (LAS float*)(lds + wave * 16384);
    constexpr int I_FF = 16 * 88;
    constexpr int I_IN = 16 * 56, I_O = 16 * 32, I_QKV = 16 * 96;
    constexpr int NITEMS = 12 * I_FF + I_IN + 2 * I_O + I_QKV;
    for (int it = gw; it < NITEMS; it += NGW) {
        int r = it; bool done = false;
#pragma unroll
        for (int f = 0; f < 4; ++f) {
            const int nf = (f == 0 ? 2 : (f == 1 ? 14 : (f == 2 ? 18 : 26)));
            bf16_t* wgu = (bf16_t*)(ws + WS_WGU + f * WGU_STRIDE); bf16_t* wd = (bf16_t*)(ws + WS_WD + f * WD_STRIDE);
            if (!done && r < I_FF) { p0_transpose_item(A_IN(nf + 1), DM, DFF, wgu, 1, scr, r, lane, A_IN(nf)); done = true; } r -= I_FF;
            if (!done && r >= 0 && r < I_FF) { p0_transpose_item(A_IN(nf + 2), DM, DFF, wgu, 2, scr, r, lane, A_IN(nf)); done = true; } r -= I_FF;
            if (!done && r >= 0 && r < I_FF) { p0_transpose_item(A_IN(nf + 3), DFF, DM, wd, 0, scr, r, lane); done = true; } r -= I_FF;
        }
        if (!done && r >= 0 && r < I_IN) { p0_transpose_item(A_IN(7), DM, ZW, (bf16_t*)(ws + WS_WIN), 0, scr, r, lane, A_IN(6)); done = true; } r -= I_IN;
        if (!done && r >= 0 && r < I_O) { p0_transpose_item(A_IN(13), DM, DM, (bf16_t*)(ws + WS_WOUT0), 0, scr, r, lane); done = true; } r -= I_O;
        if (!done && r >= 0 && r < I_QKV) { p0_transpose_item(A_IN(23), DM, QKVW, (bf16_t*)(ws + WS_WQKV), 0, scr, r, lane, A_IN(22)); done = true; } r -= I_QKV;
        if (!done && r >= 0 && r < I_O) { p0_transpose_item(A_IN(25), DM, DM, (bf16_t*)(ws + WS_WOUT1), 0, scr, r, lane); done = true; }
    }
    float* rc = (float*)(ws + WS_ROPE_C); float* rs = (float*)(ws + WS_ROPE_S);
    for (int i = gtid; i < 4096 * 8; i += gthreads) {
        const int pos = i >> 3, k = i & 7;
        const float inv = powf(500000.0f, -(float)(2 * k) / 16.0f);
        const float ang = (float)pos * inv;
        ((GAS float*)rc)[i] = cosf(ang); ((GAS float*)rs)[i] = sinf(ang);
    }
    bf16_t* sw = (bf16_t*)(ws + WS_SGUW);
    for (int i = gtid; i < 4 * 128 * 128 / 2; i += gthreads) { const f32x2 v = ((const GAS f32x2*)A_IN(10))[i]; ((GAS unsigned*)sw)[i] = pk_bf16(v.x, v.y); }
}

DI void convert_phase(const float* xin0, const float* xin1, bf16_t* XB, float* SSP, int gw, int NGW, int lane) {
    for (int m = gw; m < MT; m += NGW) {
        const GAS f32x4* xr = (const GAS f32x4*)(m < MH ? xin0 + (size_t)m * DM : xin1 + (size_t)(m - MH) * DM) + lane;
        f32x4 v[4]; float s = 0.f;
#pragma unroll
        for (int j = 0; j < 4; ++j) { v[j] = xr[64 * j]; s += (v[j].x * v[j].x + v[j].y * v[j].y) + (v[j].z * v[j].z + v[j].w * v[j].w); }
        s = wave_sum(s);
        bf16_t* ob = XB + (size_t)(m >> 7) * 32 * 4096 + (m & 127) * 32;
#pragma unroll
        for (int j = 0; j < 4; ++j) { const int cidx = 4 * lane + 256 * j; u32x2 w; w.x = pk_bf16(v[j].x, v[j].y); w.y = pk_bf16(v[j].z, v[j].w); *(GAS u32x2*)(ob + (size_t)(cidx >> 5) * 4096 + (cidx & 31)) = w; }
        if (lane < 16) ((GAS float*)SSP)[(size_t)m * 16 + lane] = lane == 0 ? s : 0.f;
    }
}
DI void final_norm_phase(const bf16_t* XB, float* out, const float* SSP, const float* gain, int gw, int NGW, int lane) {
    f32x4 g[4];
#pragma unroll
    for (int j = 0; j < 4; ++j) g[j] = ((const GAS f32x4*)gain)[lane + 64 * j];
    for (int m = gw; m < MT; m += NGW) {
        const bf16_t* xb = XB + (size_t)(m >> 7) * 32 * 4096 + (m & 127) * 32;
        u32x2 v[4];
#pragma unroll
        for (int j = 0; j < 4; ++j) { const int cidx = 4 * lane + 256 * j; v[j] = *(const GAS u32x2*)(xb + (size_t)(cidx >> 5) * 4096 + (cidx & 31)); }
        float s = ((const GAS float*)SSP)[(size_t)m * 16 + (lane & 15)];
        s += __shfl_xor(s, 1); s += __shfl_xor(s, 2); s += __shfl_xor(s, 4); s += __shfl_xor(s, 8);
        const float r = 1.0f / sqrtf(s * (1.f / DM) + EPS);
        GAS f32x4* o = (GAS f32x4*)(out + (size_t)m * DM) + lane;
#pragma unroll
        for (int j = 0; j < 4; ++j) { const f32x4 x = {bflo(v[j].x), bfhi(v[j].x), bflo(v[j].y), bfhi(v[j].y)}; o[64 * j] = x * r * g[j]; }
    }
}
template <class Sched> DI void precompute_rl(LAS unsigned char* lds, const Sched& S, const float* SSP, int tid) {
    LAS float* rl = (LAS float*)(lds + RL_OFF);
#pragma unroll 1
    for (int i0 = 0; i0 < RL_UNITS; i0 += 8) {
        f32x4 a[8], b[8]; bool ok[8];
#pragma unroll
        for (int j = 0; j < 8; ++j) {
            pg8::Unit u; ok[j] = S.next(i0 + j, u);
            if (ok[j]) { const GAS f32x4* p = (const GAS f32x4*)(SSP + (size_t)(u.pm * 256 + (tid >> 1)) * 16 + 8 * (tid & 1)); a[j] = p[0]; b[j] = p[1]; }
        }
        if (!ok[0]) break;
#pragma unroll
        for (int j = 0; j < 8; ++j) {
            if (ok[j]) {
                float s = (a[j].x + a[j].y) + (a[j].z + a[j].w) + (b[j].x + b[j].y) + (b[j].z + b[j].w);
                s += __shfl_xor(s, 1);
                if (!(tid & 1)) rl[(i0 + j) * 256 + (tid >> 1)] = 1.0f / sqrtf(s * (1.f / DM) + EPS);
            }
        }
    }
    __syncthreads();
}

template <class SF>
DI void attn_tile(f32x16& o0, f32x16& o1, float& m, float& l, const bf16x8 (&q)[4], LAS const char* Kt, LAS const char* Vt, int lane, SF sfun) {
    const int r = lane & 31, h = lane >> 5;
    f32x16 st;
#pragma unroll
    for (int i = 0; i < 16; ++i) st[i] = 0.f;
    {
        LAS const char* kp = Kt + r * 128; const int sw = r & 7;
#pragma unroll
        for (int s = 0; s < 4; ++s) { const bf16x8 kf = *(LAS const bf16x8*)(kp + (((2 * s + h) ^ sw) << 4)); st = MFMA32(kf, q[s], st); }
    }
    float mx = -1e30f;
#pragma unroll
    for (int i = 0; i < 16; ++i) { st[i] = sfun(i, st[i]); mx = fmaxf(mx, st[i]); }
    mx = fmaxf(mx, __shfl_xor(mx, 32));
    if (__any(mx > m + 8.0f)) {
        const float mn = fmaxf(m, mx), alpha = __builtin_amdgcn_exp2f(m - mn); m = mn;
        l *= alpha;
#pragma unroll
        for (int i = 0; i < 16; ++i) { o0[i] *= alpha; o1[i] *= alpha; }
    }
    float ps = 0.f;
#pragma unroll
    for (int i = 0; i < 16; ++i) { st[i] = __builtin_amdgcn_exp2f(st[i] - m); ps += st[i]; }
    l += ps;
    const int blk = (lane >> 4) & 1, q4 = (lane & 15) >> 2, p = lane & 3, rsw = 4 * h + q4;
#pragma unroll
    for (int s = 0; s < 2; ++s) {
        const bf16x8 pb = pack8(st, s);
        LAS const char* vrow = Vt + (16 * s + 4 * h + q4) * 128 + 8 * (p & 1);
#pragma unroll
        for (int dt = 0; dt < 2; ++dt) {
            const int ch = ((4 * dt + 2 * blk + (p >> 1)) ^ rsw) << 4;
            const s16x4 lo = tr_read(vrow + ch), hi = tr_read(vrow + 8 * 128 + ch);
            const bf16x8 vf = __builtin_shufflevector(lo, hi, 0, 1, 2, 3, 4, 5, 6, 7);
            if (dt == 0) o0 = MFMA32(vf, pb, o0); else o1 = MFMA32(vf, pb, o1);
        }
    }
}
template <class SF0, class SF1>
DI void attn_tile2(f32x16& o0, f32x16& o1, float& m, float& l, const bf16x8 (&q)[4], LAS const char* K0, LAS const char* V0, LAS const char* K1, LAS const char* V1, int lane, SF0 f0, SF1 f1) {
    const int r = lane & 31, h = lane >> 5;
    f32x16 sa, sb;
#pragma unroll
    for (int i = 0; i < 16; ++i) { sa[i] = 0.f; sb[i] = 0.f; }
    {
        const int sw = r & 7; LAS const char* kp0 = K0 + r * 128; LAS const char* kp1 = K1 + r * 128;
#pragma unroll
        for (int s = 0; s < 4; ++s) {
            const int co = (((2 * s + h) ^ sw) << 4);
            const bf16x8 ka = *(LAS const bf16x8*)(kp0 + co), kb = *(LAS const bf16x8*)(kp1 + co);
            sa = MFMA32(ka, q[s], sa); sb = MFMA32(kb, q[s], sb);
        }
    }
    float mx = -1e30f;
#pragma unroll
    for (int i = 0; i < 16; ++i) { sa[i] = f0(i, sa[i]); sb[i] = f1(i, sb[i]); mx = fmaxf(fmaxf(mx, sa[i]), sb[i]); }
    mx = fmaxf(mx, __shfl_xor(mx, 32));
    if (__any(mx > m + 8.0f)) {
        const float mn = fmaxf(m, mx), alpha = __builtin_amdgcn_exp2f(m - mn); m = mn;
        l *= alpha;
#pragma unroll
        for (int i = 0; i < 16; ++i) { o0[i] *= alpha; o1[i] *= alpha; }
    }
    float ps = 0.f;
#pragma unroll
    for (int i = 0; i < 16; ++i) { sa[i] = __builtin_amdgcn_exp2f(sa[i] - m); sb[i] = __builtin_amdgcn_exp2f(sb[i] - m); ps += sa[i] + sb[i]; }
    l += ps;
    const int blk = (lane >> 4) & 1, q4 = (lane & 15) >> 2, p = lane & 3, rsw = 4 * h + q4;
#pragma unroll
    for (int s = 0; s < 2; ++s) {
        const bf16x8 fa = pack8(sa, s), fb = pack8(sb, s);
        const int ro = (16 * s + 4 * h + q4) * 128 + 8 * (p & 1);
#pragma unroll
        for (int dt = 0; dt < 2; ++dt) {
            const int ch = ((4 * dt + 2 * blk + (p >> 1)) ^ rsw) << 4;
            const s16x4 alo = tr_read(V0 + ro + ch), ahi = tr_read(V0 + ro + 8 * 128 + ch), blo = tr_read(V1 + ro + ch), bhi = tr_read(V1 + ro + 8 * 128 + ch);
            const bf16x8 vfa = __builtin_shufflevector(alo, ahi, 0, 1, 2, 3, 4, 5, 6, 7), vfb = __builtin_shufflevector(blo, bhi, 0, 1, 2, 3, 4, 5, 6, 7);
            if (dt == 0) { o0 = MFMA32(vfa, fa, o0); o0 = MFMA32(vfb, fb, o0); } else { o1 = MFMA32(vfa, fa, o1); o1 = MFMA32(vfb, fb, o1); }
        }
    }
}
DI void attn_store(const f32x16& o0, const f32x16& o1, float inv_l, bf16_t* orow  , int h) {
#pragma unroll
    for (int i4 = 0; i4 < 4; ++i4) {
        u32x2 w0, w1;
        w0.x = pk_bf16(o0[4 * i4] * inv_l, o0[4 * i4 + 1] * inv_l); w0.y = pk_bf16(o0[4 * i4 + 2] * inv_l, o0[4 * i4 + 3] * inv_l);
        w1.x = pk_bf16(o1[4 * i4] * inv_l, o1[4 * i4 + 1] * inv_l); w1.y = pk_bf16(o1[4 * i4 + 2] * inv_l, o1[4 * i4 + 3] * inv_l);
        *(GAS u32x2*)(orow + 8 * i4 + 4 * h) = w0; *(GAS u32x2*)(orow + 4096 + 8 * i4 + 4 * h) = w1;
    }
}
DI void rope16(u32x4& a, u32x4& b, const float* rc, const float* rs, int pos) {
    const f32x4 c0 = *(const GAS f32x4*)(rc + pos * 8), c1 = *(const GAS f32x4*)(rc + pos * 8 + 4), s0 = *(const GAS f32x4*)(rs + pos * 8), s1 = *(const GAS f32x4*)(rs + pos * 8 + 4);
    const float cs[8] = {c0.x, c0.y, c0.z, c0.w, c1.x, c1.y, c1.z, c1.w}, sn[8] = {s0.x, s0.y, s0.z, s0.w, s1.x, s1.y, s1.z, s1.w};
    const unsigned av[4] = {a.x, a.y, a.z, a.w}, bv[4] = {b.x, b.y, b.z, b.w};
    unsigned ao[4], bo[4];
#pragma unroll
    for (int j = 0; j < 4; ++j) {
        const float x1l = bflo(av[j]), x1h = bfhi(av[j]), x2l = bflo(bv[j]), x2h = bfhi(bv[j]);
        ao[j] = pk_bf16(x1l * cs[2 * j] - x2l * sn[2 * j], x1h * cs[2 * j + 1] - x2h * sn[2 * j + 1]);
        bo[j] = pk_bf16(x2l * cs[2 * j] + x1l * sn[2 * j], x2h * cs[2 * j + 1] + x1h * sn[2 * j + 1]);
    }
    a = (u32x4){ao[0], ao[1], ao[2], ao[3]}; b = (u32x4){bo[0], bo[1], bo[2], bo[3]};
}

DI void swa_unit(LAS unsigned char* ldsu, const bf16_t* Z, bf16_t* AB, const float* rc, const float* rs, const float* sink, int rowbase, int b, int n, int g, int L, int tid) {
    LAS char* lds = (LAS char*)ldsu;
    const int lane = tid & 63, w = tid >> 6, r = lane & 31, h = lane >> 5;
    LAS char* Ks = lds; LAS char* Vs = lds + 49152;
    for (int it = tid; it < 1536; it += NTHREADS) {
        const int kr = it >> 2, seg = it & 3, pos = 128 * (n - 1) + kr;
        if (pos < 0 || pos >= L) continue;
        const size_t zr = (size_t)(rowbase + b * L + pos);
        const bf16_t* kp = Z + toff(zr, 1536 + 64 * g + 16 * seg, ZW / 32); const bf16_t* vp = Z + toff(zr, 1664 + 64 * g + 16 * seg, ZW / 32);
        u32x4 k0 = *(const GAS u32x4*)kp, k1 = *(const GAS u32x4*)(kp + 8);
        const u32x4 v0 = *(const GAS u32x4*)vp, v1 = *(const GAS u32x4*)(vp + 8);
        if (seg == 0) rope16(k0, k1, rc, rs, pos);
        const int sw = kr & 7, c0 = ((2 * seg) ^ sw) << 4, c1 = ((2 * seg + 1) ^ sw) << 4;
        *(LAS u32x4*)(Ks + kr * 128 + c0) = k0; *(LAS u32x4*)(Ks + kr * 128 + c1) = k1;
        *(LAS u32x4*)(Vs + kr * 128 + c0) = v0; *(LAS u32x4*)(Vs + kr * 128 + c1) = v1;
    }
    __syncthreads();
#pragma unroll 1
    for (int qq = 0; qq < 2; ++qq) {
        const int qi = 2 * w + qq, r4 = qi >> 2, qt = qi & 3, head = 4 * g + r4;
        const int qpos = 128 * n + 32 * qt + r;
        const size_t qr_ = (size_t)(rowbase + b * L + qpos);
        bf16x8 q[4];
#pragma unroll
        for (int s = 0; s < 4; ++s) q[s] = *(const GAS bf16x8*)(Z + toff(qr_, 1024 + 64 * head + 16 * s + 8 * h, ZW / 32));
        {
            const u32x4 mine = __builtin_bit_cast(u32x4, q[0]);
            u32x4 oth; oth.x = __shfl_xor(mine.x, 32); oth.y = __shfl_xor(mine.y, 32); oth.z = __shfl_xor(mine.z, 32); oth.w = __shfl_xor(mine.w, 32);
            const f32x4 c0 = *(const GAS f32x4*)(rc + qpos * 8), c1 = *(const GAS f32x4*)(rc + qpos * 8 + 4), s0 = *(const GAS f32x4*)(rs + qpos * 8), s1 = *(const GAS f32x4*)(rs + qpos * 8 + 4);
            const float cs[8] = {c0.x, c0.y, c0.z, c0.w, c1.x, c1.y, c1.z, c1.w}, sn[8] = {s0.x, s0.y, s0.z, s0.w, s1.x, s1.y, s1.z, s1.w};
            const unsigned mv[4] = {mine.x, mine.y, mine.z, mine.w}, ov[4] = {oth.x, oth.y, oth.z, oth.w};
            const float sg = h ? 1.f : -1.f; unsigned res[4];
#pragma unroll
            for (int j = 0; j < 4; ++j) res[j] = pk_bf16(bflo(mv[j]) * cs[2 * j] + sg * bflo(ov[j]) * sn[2 * j], bfhi(mv[j]) * cs[2 * j + 1] + sg * bfhi(ov[j]) * sn[2 * j + 1]);
            q[0] = __builtin_bit_cast(bf16x8, (u32x4){res[0], res[1], res[2], res[3]});
        }
        f32x16 o0, o1;
#pragma unroll
        for (int i = 0; i < 16; ++i) { o0[i] = 0.f; o1[i] = 0.f; }
        float m = -1e30f, l = 0.f;
        {
            const int nb = L / 128;
            const int dk_lo = n == 0 ? (4 - qt > 0 ? 4 - qt : 0) : 0, dk_hi = n == nb - 1 ? (7 - qt < 8 ? 7 - qt : 8) : 8;
            if (dk_lo == 0) attn_tile(o0, o1, m, l, q, Ks + qt * 4096, Vs + qt * 4096, lane, [&](int i, float s) { return crow(i, h) >= r ? s * C2 : -1e30f; });
            int d = dk_lo > 1 ? dk_lo : 1; const int de = dk_hi < 7 ? dk_hi : 7;
#pragma unroll 1
            for (; d + 1 <= de; d += 2) { const int kt = qt + d;
                attn_tile2(o0, o1, m, l, q, Ks + kt * 4096, Vs + kt * 4096, Ks + (kt + 1) * 4096, Vs + (kt + 1) * 4096, lane, [&](int i, float s) { return s * C2; }, [&](int i, float s) { return s * C2; }); }
            if (d <= de) attn_tile(o0, o1, m, l, q, Ks + (qt + d) * 4096, Vs + (qt + d) * 4096, lane, [&](int i, float s) { return s * C2; });
            if (dk_hi == 8) attn_tile(o0, o1, m, l, q, Ks + (qt + 8) * 4096, Vs + (qt + 8) * 4096, lane, [&](int i, float s) { return crow(i, h) <= r ? s * C2 : -1e30f; });
        }
        const float lt = l + __shfl_xor(l, 32) + __builtin_amdgcn_exp2f(((const GAS float*)sink)[head] * LOG2E - m);
        attn_store(o0, o1, 1.0f / lt, AB + toff(qr_, 512 + 64 * head, DM / 32), h);
    }
    __syncthreads();
}

constexpr int SGU_PITCH = 1040;
DI void sgu_unit(LAS unsigned char* ldsu, const bf16_t* Z, bf16_t* AB, const bf16_t* SW, const float* sgu_b, const float* ln_g, const float* ln_b, int t0, int tid) {
    LAS char* lds = (LAS char*)ldsu;
    const int lane = tid & 63, w = tid >> 6, r = lane & 31, h = lane >> 5;
    const int g = w >> 1, chf = w & 1;
    const bf16_t* wg = SW + (size_t)g * 128 * 128 + (size_t)r * 128 + 8 * h;
    {
        const f32x4 g0 = *(const GAS f32x4*)(ln_g + 8 * lane), g1 = *(const GAS f32x4*)(ln_g + 8 * lane + 4), b0 = *(const GAS f32x4*)(ln_b + 8 * lane), b1 = *(const GAS f32x4*)(ln_b + 8 * lane + 4);
#pragma unroll 1
        for (int tb = 0; tb < 16; tb += 8) {
        u32x4 zv[8];
#pragma unroll
        for (int t = 0; t < 8; ++t) zv[t] = *(const GAS u32x4*)(Z + toff((size_t)(t0 + 16 * w + tb + t), 512 + 8 * lane, ZW / 32));
#pragma unroll
        for (int t = 0; t < 8; ++t) {
            const int tok = 16 * w + tb + t;
            f32x4 x0 = {bflo(zv[t].x), bfhi(zv[t].x), bflo(zv[t].y), bfhi(zv[t].y)}, x1 = {bflo(zv[t].z), bfhi(zv[t].z), bflo(zv[t].w), bfhi(zv[t].w)};
            const float mu = wave_sum((x0.x + x0.y) + (x0.z + x0.w) + (x1.x + x1.y) + (x1.z + x1.w)) * (1.f / 512.f);
            x0 = x0 - mu; x1 = x1 - mu;
            const float var = wave_sum((x0.x * x0.x + x0.y * x0.y) + (x0.z * x0.z + x0.w * x0.w) + (x1.x * x1.x + x1.y * x1.y) + (x1.z * x1.z + x1.w * x1.w)) * (1.f / 512.f);
            const float rstd = 1.0f / sqrtf(var + EPS);
            const f32x4 y0 = x0 * rstd * g0 + b0, y1 = x1 * rstd * g1 + b1;
            u32x4 o; o.x = pk_bf16(y0.x, y0.y); o.y = pk_bf16(y0.z, y0.w); o.z = pk_bf16(y1.x, y1.y); o.w = pk_bf16(y1.z, y1.w);
            *(LAS u32x4*)(lds + tok * SGU_PITCH + 16 * lane) = o;
        }
        }
    }
    __syncthreads();
    const int blk = (lane >> 4) & 1, q4 = (lane & 15) >> 2, p = lane & 3;
    LAS const char* abase = lds + (8 * h + q4) * SGU_PITCH + (128 * g + 64 * chf + 16 * blk) * 2 + 8 * p;
#pragma unroll
    for (int it = 0; it < 4; ++it) {
        const int tok = 32 * it + r;
        const bf16_t* urow = Z + toff((size_t)(t0 + tok), 128 * g + 64 * chf, ZW / 32) + 4 * h;
        u32x2 uu[2][4];
#pragma unroll
        for (int ct = 0; ct < 2; ++ct)
#pragma unroll
            for (int i4 = 0; i4 < 4; ++i4) uu[ct][i4] = *(const GAS u32x2*)(urow + 4096 * ct + 8 * i4);
        const float bias = ((const GAS float*)sgu_b)[g * 128 + tok];
        bf16x8 bcur[8];
#pragma unroll
        for (int s = 0; s < 8; ++s) bcur[s] = *(const GAS bf16x8*)(wg + (size_t)(32 * it) * 128 + 16 * s);
        f32x16 acc[2];
#pragma unroll
        for (int ct = 0; ct < 2; ++ct)
#pragma unroll
            for (int i = 0; i < 16; ++i) acc[ct][i] = 0.f;
#pragma unroll
        for (int s = 0; s < 8; ++s) {
#pragma unroll
            for (int ct = 0; ct < 2; ++ct) {
                LAS const char* base = abase + 16 * s * SGU_PITCH + 64 * ct;
                const s16x4 lo = tr_read(base), hi = tr_read(base + 4 * SGU_PITCH);
                const bf16x8 af = __builtin_shufflevector(lo, hi, 0, 1, 2, 3, 4, 5, 6, 7);
                acc[ct] = MFMA32(af, bcur[s], acc[ct]);
            }
        }
        bf16_t* orow = AB + toff((size_t)(t0 + tok), 128 * g + 64 * chf, DM / 32) + 4 * h;
#pragma unroll
        for (int ct = 0; ct < 2; ++ct)
#pragma unroll
            for (int i4 = 0; i4 < 4; ++i4) {
                const u32x2 u2 = uu[ct][i4];
                u32x2 o; o.x = pk_bf16(bflo(u2.x) * (acc[ct][4 * i4] + bias), bfhi(u2.x) * (acc[ct][4 * i4 + 1] + bias));
                o.y = pk_bf16(bflo(u2.y) * (acc[ct][4 * i4 + 2] + bias), bfhi(u2.y) * (acc[ct][4 * i4 + 3] + bias));
                *(GAS u32x2*)(orow + 4096 * ct + 8 * i4) = o;
            }
    }
    __syncthreads();
}

DI void na_unit(LAS unsigned char* ldsu, bf16_t* QO  , const bf16_t* KV  , const float* rpb, int b, int hh, int rg, int L, int tid) {
    LAS char* lds = (LAS char*)ldsu;
    const int lane = tid & 63, w = tid >> 6, r = lane & 31, h = lane >> 5;
    const int rows = L / 64, r0 = 4 * rg;
    const int lo = clampi(r0 - 4, 0, rows - 8), hiE = clampi(r0 - 1, 0, rows - 8) + 8;
    LAS float* rpbL = (LAS float*)(lds + 65536);
    for (int i = tid; i < 15 * 128; i += NTHREADS) { const int dr = i >> 7, dc = (i & 127) - 48; rpbL[i] = (dc >= 0 && dc < 31) ? ((const GAS float*)rpb)[hh * 465 + dr * 31 + dc] * LOG2E : 0.f; }
    const int cg = w & 3, qrA = r0 + 2 * (w >> 2);
    const int qr = qrA + (r >> 4), c = 16 * cg + (r & 15), rsb = clampi(qr - 4, 0, rows - 8), cs = clampi(c - 8, 0, 48);
    const int cs0 = clampi(16 * cg - 8, 0, 32), rsA = clampi(qrA - 4, 0, rows - 8), rsB = clampi(qrA - 3, 0, rows - 8);
    const size_t tokq = (size_t)b * L + 64 * qr + c;
    bf16x8 q[4];
#pragma unroll
    for (int s = 0; s < 4; ++s) q[s] = *(const GAS bf16x8*)(QO + toff(tokq, 64 * hh + 16 * s + 8 * h, DM / 32));
    f32x16 o0, o1;
#pragma unroll
    for (int i = 0; i < 16; ++i) { o0[i] = 0.f; o1[i] = 0.f; }
    float m = -1e30f, l = 0.f;
    float madd[16];
#pragma unroll
    for (int i = 0; i < 16; ++i) { const int kcol = cs0 + crow(i, h); madd[i] = (kcol >= cs && kcol < cs + 16) ? 0.f : -1e30f; }
    const int kc = tid >> 3, chunk = tid & 7;
    constexpr int KVW = 2048;
    (void)KVW;
#define NA_KOFF(row_) toff((size_t)b * L + 64 * (row_) + kc, 64 * hh + 8 * chunk, 64)
    const int stoff = kc * 128 + ((chunk ^ (kc & 7)) << 4);
    u32x4 kreg[4], vreg[4];
#pragma unroll
    for (int j = 0; j < 4; ++j) if (lo + j < hiE) { const bf16_t* kp_ = KV + NA_KOFF(lo + j); kreg[j] = *(const GAS u32x4*)kp_; vreg[j] = *(const GAS u32x4*)(kp_ + 131072); }
    int cur = 0;
#pragma unroll 1
    for (int base = lo; base < hiE; base += 4) {
#pragma unroll
        for (int j = 0; j < 4; j += 2) {
            const int kr = base + j;
            if (kr < hiE) {
                LAS char* Kb = lds + cur * 32768; LAS char* Vb = Kb + 8192;
                *(LAS u32x4*)(Kb + stoff) = kreg[j]; *(LAS u32x4*)(Vb + stoff) = vreg[j];
                if (kr + 1 < hiE) { *(LAS u32x4*)(Kb + 16384 + stoff) = kreg[j + 1]; *(LAS u32x4*)(Vb + 16384 + stoff) = vreg[j + 1]; }
                LDS_BARRIER();
                if (kr + 4 < hiE) { const bf16_t* kp_ = KV + NA_KOFF(kr + 4); kreg[j] = *(const GAS u32x4*)kp_; vreg[j] = *(const GAS u32x4*)(kp_ + 131072); }
                if (kr + 5 < hiE) { const bf16_t* kp_ = KV + NA_KOFF(kr + 5); kreg[j + 1] = *(const GAS u32x4*)kp_; vreg[j + 1] = *(const GAS u32x4*)(kp_ + 131072); }
                if (kr + 1 >= rsA && kr < rsB + 8) {
                    LAS const float* brow0 = rpbL + clampi(kr - qr + 7, 0, 14) * 128 + 63 - c + cs0 + 4 * h;
                    LAS const float* brow1 = rpbL + clampi(kr + 1 - qr + 7, 0, 14) * 128 + 63 - c + cs0 + 4 * h;
                    const float radd0 = (kr >= rsb && kr < rsb + 8) ? 0.f : -1e30f, radd1 = (kr + 1 >= rsb && kr + 1 < rsb + 8) ? 0.f : -1e30f;
                    attn_tile2(o0, o1, m, l, q, Kb + cs0 * 128, Vb + cs0 * 128, Kb + 16384 + cs0 * 128, Vb + 16384 + cs0 * 128, lane,
                        [&](int i, float s) { return fmaf(s, C2, brow0[(i & 3) + 8 * (i >> 2)]) + (madd[i] + radd0); },
                        [&](int i, float s) { return fmaf(s, C2, brow1[(i & 3) + 8 * (i >> 2)]) + (madd[i] + radd1); });
                }
                cur ^= 1;
            }
        }
    }
    const float lt = l + __shfl_xor(l, 32);
    attn_store(o0, o1, 1.0f / lt, QO + toff(tokq, 64 * hh, DM / 32), h);
    __syncthreads();
}

#define XB_TMO      128
#define XB_XCNT(j)  (256  + 64 * (j))
#define XB_XSUB(j)  (1280 + 64 * (j))
#define XB_XGEN(j)  (2304 + 64 * (j))
#define XB_TOP      3328
#define XB_TOPGEN   3392
#define XCD_BAR_WORDS 3456
#define XB_SPIN_CAP (1u << 18)

__device__ __forceinline__ unsigned xb_ld(unsigned* p)              { return __hip_atomic_load(p, __ATOMIC_RELAXED, __HIP_MEMORY_SCOPE_AGENT); }
__device__ __forceinline__ unsigned xb_add(unsigned* p, unsigned v) { return __hip_atomic_fetch_add(p, v, __ATOMIC_RELAXED, __HIP_MEMORY_SCOPE_AGENT); }
__device__ __forceinline__ unsigned xb_xcc_id() { return (unsigned)__builtin_amdgcn_s_getreg((3 << 11) | 20) & 0xFu; }
#define XB_SPIN(cond, bar) do { unsigned _sp = 0; while (cond) { __builtin_amdgcn_s_sleep(1); \
    if ((++_sp & 255u) == 0u) { if (xb_ld(&(bar)[XB_TMO])) break; if (_sp > XB_SPIN_CAP) { atomicAdd(&(bar)[XB_TMO], 1u); break; } } } } while (0)

struct XcdBarrier {
    unsigned* bar; unsigned x;
    volatile LAS unsigned* st;
};

__device__ __forceinline__ XcdBarrier xcd_barrier_post(unsigned* bar, volatile LAS unsigned* st) {
    XcdBarrier b; b.bar = bar; b.x = xb_xcc_id(); b.st = st;
    if (threadIdx.x == 0) (void)xb_add(&bar[XB_XCNT(b.x)], 1u);
    return b;
}
__device__ __forceinline__ void xcd_barrier_complete(unsigned* bar, unsigned x, unsigned& nloc, unsigned& nx) {
    const unsigned G = gridDim.x * gridDim.y * gridDim.z;
    unsigned sum, cnt, mine, sp = 0u;
    for (;;) {
        sum = 0u; cnt = 0u; mine = 0u;
#pragma unroll
        for (unsigned j = 0; j < 16; ++j) { const unsigned c = xb_ld(&bar[XB_XCNT(j)]); sum += c; cnt += (c > 0u) ? 1u : 0u; mine = (j == x) ? c : mine; }
        if (sum == G) break;
        __builtin_amdgcn_s_sleep(1);
        if ((++sp & 255u) == 0u) { if (xb_ld(&bar[XB_TMO])) break; if (sp > XB_SPIN_CAP) { atomicAdd(&bar[XB_TMO], 1u); break; } }
    }
    nloc = mine > 0u ? mine : 1u; nx = cnt > 0u ? cnt : 1u;
}

__device__ __forceinline__ void xcd_barrier(const XcdBarrier& b) {
    asm volatile("s_waitcnt vmcnt(0)" ::: "memory");
    __syncthreads();
    if (threadIdx.x == 0) {
        unsigned* bar = b.bar;
        __builtin_amdgcn_s_waitcnt(0);
        unsigned nloc = b.st[0], nx = b.st[1];
        if (nloc == 0u) { xcd_barrier_complete(bar, b.x, nloc, nx); b.st[0] = nloc; b.st[1] = nx; }
        const unsigned old = xb_add(&bar[XB_XSUB(b.x)], 1u);
        const unsigned gen = old / nloc;
        if (old + 1u == (gen + 1u) * nloc) {
            __builtin_amdgcn_fence(__ATOMIC_RELEASE, "agent");
            asm volatile("s_waitcnt vmcnt(0)" ::: "memory");
            const unsigned og = xb_add(&bar[XB_TOP], 1u);
            const unsigned tg = og / nx;
            if (og + 1u == (tg + 1u) * nx) xb_add(&bar[XB_TOPGEN], 1u);
            else XB_SPIN(xb_ld(&bar[XB_TOPGEN]) == tg, bar);
            __builtin_amdgcn_fence(__ATOMIC_ACQUIRE, "agent");
            xb_add(&bar[XB_XGEN(b.x)], 1u);
            asm volatile("s_waitcnt vmcnt(0)" ::: "memory");
        } else {
            XB_SPIN(xb_ld(&bar[XB_XGEN(b.x)]) == gen, bar);
            __builtin_amdgcn_fence(__ATOMIC_ACQUIRE, "agent");
            asm volatile("s_waitcnt vmcnt(0)" ::: "memory");
        }
    }
    __syncthreads();
}

constexpr size_t WS_BAR = WS_CTL + 16384;

typedef const __attribute__((address_space(4))) char* kargp_t;
#define KARG_PTR(T, k) ((T)(*(const unsigned long long volatile __attribute__((address_space(4)))*)((kargp_t)__builtin_amdgcn_kernarg_segment_ptr() + 8 * (k))))
#define KARG_IN(k) KARG_PTR(const float*, (k))
#define KARG_OUT() KARG_PTR(float*, 31)
#define KARG_WS() KARG_PTR(unsigned char*, 32)

__global__ void __launch_bounds__(NTHREADS, 2) fwd_megakernel(Args args) {
    extern __shared__ __attribute__((aligned(16))) unsigned char lds_raw[];
    LAS unsigned char* lds = (LAS unsigned char*)lds_raw;
    cg::grid_group grid = cg::this_grid();
    const int ph_lo = args.ph_lo, ph_hi = args.ph_hi;
    if (threadIdx.x < 16) ((LAS unsigned*)(lds + MISC_OFF))[threadIdx.x] = 0u;
    __syncthreads();
    XcdBarrier xbar; xbar.bar = (unsigned*)(KARG_WS() + WS_BAR); xbar.x = xb_xcc_id(); xbar.st = (volatile LAS unsigned*)(lds + MISC_OFF);
    if (threadIdx.x == 0) { const unsigned rank = xb_add(&xbar.bar[XB_XCNT(xbar.x)], 1u); xbar.st[4] = xbar.x + 8u * rank; xbar.st[5] = 0u; }
    __syncthreads();

#ifndef PROBE_DUP
#define PROBE_DUP 0u
#endif
    int rep = 0;
#pragma unroll 1
    for (int ph = ph_lo; ph < ph_hi;) {
        int tid = threadIdx.x; asm volatile("" : "+v"(tid));
        const int lane = tid & 63, wave = __builtin_amdgcn_readfirstlane(tid >> 6);
        int G = gridDim.x, bx = blockIdx.x; asm volatile("" : "+s"(G), "+s"(bx));
        const int bxg = __builtin_amdgcn_readfirstlane(xbar.st[5] ? (int)xbar.st[4] : bx);
        const int gw = bx * NWAVES + wave, NGW = G * NWAVES;
        unsigned char* ws = KARG_WS();
        unsigned char* wb = (unsigned char*)KARG_OUT();
        bf16_t* XN = (bf16_t*)(ws + WS_XN); bf16_t* BIG = (bf16_t*)(ws + WS_BIG); bf16_t* AB = (bf16_t*)(ws + WS_AB);
        float* SSP = (float*)(ws + WS_SSP);
        if (ph == 0) {
#ifndef NO_P0
            p0_phase(wb, lds, gw, NGW, wave, lane, bx * NTHREADS + tid, G * NTHREADS);
#endif
            convert_phase(KARG_IN(0), KARG_IN(1), XN, SSP, gw, NGW, lane);
        } else if (ph == 1 || ph == 6 || ph == 8 || ph == 16) {
#ifndef NO_G1
            const int f = ph == 1 ? 0 : ph == 6 ? 1 : ph == 8 ? 2 : 3;
            pg8::Gemm g{XN, (const bf16_t*)(wb + WS_WGU + f * WGU_STRIDE), MT, 2 * DFF, DM, 1}; pg8::StaticOrder S; S.init(MT, 2 * DFF, G, bxg);
            precompute_rl(lds, S, SSP, tid);
            pg8::EpiSwiGLU E{BIG, DFF, (const LAS float*)(lds + RL_OFF)};
            pg8::gemm_phase<pg8::EpiSwiGLU, pg8::StaticOrder, true, true>(lds, g, S, E);
#endif
        } else if (ph == 2 || ph == 7 || ph == 9 || ph == 17 || ph == 5 || ph == 12 || ph == 15) {
#ifndef NO_G2
            const bool ffn = !(ph == 5 || ph == 12 || ph == 15);
            const int f = ph == 2 ? 0 : ph == 7 ? 1 : ph == 9 ? 2 : 3;
            const int M = (ph == 12 || ph == 15) ? MH : MT;
            const size_t rb = ph == 15 ? (size_t)MH : 0;
            const bf16_t* A = ffn ? BIG : (ph == 5 ? AB : BIG  );
            const bf16_t* Bt = ffn ? (const bf16_t*)(wb + WS_WD + f * WD_STRIDE) : (const bf16_t*)(wb + (ph == 5 ? WS_WOUT0 : WS_WOUT1));
            pg8::Gemm g{A, Bt, M, DM, ffn ? DFF : DM, 1  }; pg8::StaticOrder S; S.init(M, DM, G, bxg);
            bf16_t* xb = XN + rb * DM;
            pg8::EpiResidual E{ffn ? 0.5f : 1.0f, xb, SSP + rb * 16, (PROBE_DUP != 0u && rep == 0 && ((PROBE_DUP >> ph) & 1u)) ? (bf16_t*)(ws + WS_END) : xb};
            pg8::gemm_phase<pg8::EpiResidual, pg8::StaticOrder, true, true>(lds, g, S, E);
#endif
        } else if (ph == 3 || ph == 10 || ph == 13) {
#ifndef NO_G3
            const int N = ph == 3 ? ZW : QKVW, M = ph == 3 ? MT : MH;
            const size_t rb = ph == 13 ? (size_t)MH : 0;
            pg8::Gemm g{XN + rb * DM, (const bf16_t*)(wb + (ph == 3 ? WS_WIN : WS_WQKV)), M, N, DM, 1}; pg8::StaticOrder S; S.init(M, N, G, bxg);
            precompute_rl(lds, S, SSP + rb * 16, tid);
            pg8::EpiBf16G E{BIG, ph == 3 ? ZW : DM, ph == 3 ? 4 : 0, (const LAS float*)(lds + RL_OFF), ph == 3 ? 1000 : 4, (bf16_t*)(ws + WS_KV), 2048};
            pg8::gemm_phase<pg8::EpiBf16G, pg8::StaticOrder, true, true>(lds, g, S, E);
#endif
        } else if (ph == 4) {
            const float* rc = (const float*)(wb + WS_ROPE_C); const float* rs = (const float*)(wb + WS_ROPE_S);
            constexpr int nchunks = MT / 128;
#ifndef NO_SWA
#pragma unroll 1
            for (int idx = bx; idx < 2 * nchunks; idx += G) {
                const int chunk = idx >> 1, g = idx & 1, hf = chunk >= 256, cl = chunk & 255, L = hf ? 2048 : 4096, nb = L / 128;
                swa_unit(lds, BIG, AB, rc, rs, KARG_IN(12), hf ? MH : 0, cl / nb, cl % nb, g, L, tid);
            }
#endif
#ifndef NO_SGU
#pragma unroll 1
            for (int idx = bx; idx < nchunks; idx += G) sgu_unit(lds, BIG, AB, (const bf16_t*)(wb + WS_SGUW), KARG_IN(11), KARG_IN(8), KARG_IN(9), idx * 128, tid);
#endif
        } else if (ph == 11 || ph == 14) {
#ifndef NO_NA
            const int L = ph == 14 ? 2048 : 4096;
            const int nrg = L / 256, nunits = (MH / L) * 16 * nrg;
#pragma unroll 1
            for (int idx = bx; idx < nunits; idx += G) { const int hh = idx & 15, rg = (idx >> 4) % nrg, b = (idx >> 4) / nrg; na_unit(lds, BIG, (const bf16_t*)(ws + WS_KV), KARG_IN(24), b, hh, rg, L, tid); }
#endif
        } else {
            final_norm_phase(XN, KARG_OUT(), SSP, KARG_IN(30), gw, NGW, lane);
        }
        if (PROBE_DUP != 0u && rep == 0 && ((PROBE_DUP >> ph) & 1u)) { rep = 1; xcd_barrier(xbar); continue; }
        rep = 0;
        if (ph + 1 < ph_hi) {
            if (ph == 0) {
                grid.sync();
                if (threadIdx.x == 0) {
                    const unsigned Gn = gridDim.x; unsigned even = (Gn % 8u == 0u) ? 1u : 0u;
                    for (unsigned j = 0; j < 16; ++j) { const unsigned cnt = xb_ld(&xbar.bar[XB_XCNT(j)]); if (cnt != (j < 8 ? Gn / 8u : 0u)) even = 0u; }
                    xbar.st[5] = even;
                }
                __syncthreads();
            } else xcd_barrier(xbar);
        }
        ++ph;
    }
}

extern "C" void kernel_launch(void* const* d_in, const int* in_sizes, int n_in, void* d_out, int out_size, void* d_ws, size_t ws_size, hipStream_t stream) {
    static int grid = 0;
    if (grid == 0) {
        if (n_in != 31 || out_size != MT * DM || ws_size < WS_END) { fprintf(stderr, "kernel_launch: unexpected shapes (n_in %d out %d ws %zu)\n", n_in, out_size, ws_size); grid = -1; return; }
        int dev = 0, cus = 0, per_cu = 0;
        hipGetDevice(&dev); hipDeviceGetAttribute(&cus, hipDeviceAttributeMultiprocessorCount, dev);
        if (hipFuncSetAttribute((const void*)fwd_megakernel, hipFuncAttributeMaxDynamicSharedMemorySize, LDS_BYTES) != hipSuccess) { fprintf(stderr, "kernel_launch: hipFuncSetAttribute failed\n"); grid = -1; return; }
        if (hipOccupancyMaxActiveBlocksPerMultiprocessor(&per_cu, (const void*)fwd_megakernel, NTHREADS, LDS_BYTES) != hipSuccess || per_cu < 1) { fprintf(stderr, "kernel_launch: occupancy query says %d\n", per_cu); per_cu = 1; }
        (void)hipGetLastError();
        grid = cus * per_cu;
        fprintf(stderr, "kernel_launch: grid %d (cus %d x %d)\n", grid, cus, per_cu);
    }
    if (grid < 0) return;
    if (hipMemsetAsync((char*)d_ws + WS_CTL, 0, 65536, stream) != hipSuccess) { fprintf(stderr, "kernel_launch: memset failed\n"); return; }
    Args a{};
    for (int i = 0; i < 31; ++i) a.in[i] = (const float*)d_in[i];
    a.out = (float*)d_out; a.ws = (unsigned char*)d_ws;
#if MK_SINGLE
    a.ph_lo = 0; a.ph_hi = NPHASES;
    void* kargs[] = {&a};
    hipError_t e = hipLaunchCooperativeKernel((const void*)fwd_megakernel, dim3(grid), dim3(NTHREADS), kargs, LDS_BYTES, stream);
    if (e != hipSuccess) fprintf(stderr, "cooperative launch failed: %s (grid %d)\n", hipGetErrorString(e), grid);
#else
    for (int ph = 0; ph < NPHASES; ++ph) {
        a.ph_lo = ph; a.ph_hi = ph + 1;
        hipLaunchKernelGGL(fwd_megakernel, dim3(grid), dim3(NTHREADS), LDS_BYTES, stream, a);
    }
#endif
}
```
